# Optimizing an MI355X kernel written in HIP

```python
import math
import jax, jax.numpy as jnp
from jax import lax
import numpy as np

D_MODEL = 1024
BATCH = 8
SEQ = 4096
DEPTH = 4

N_A = DEPTH // 2
N_B = DEPTH - N_A
POOL_WINDOWS = (2, 4, 8, 16)
N_POOL_GROUPS = len(POOL_WINDOWS)
GROUP_CH = D_MODEL // N_POOL_GROUPS
HEAD_DIM = 64
N_Q_HEADS = D_MODEL // HEAD_DIM
N_KV_HEADS = 4
Q_PER_KV = N_Q_HEADS // N_KV_HEADS
WINDOW = 128
BLOCK = 128
ROPE_THETA = 10000.0
ATTN_SCALE = 1.0 / math.sqrt(HEAD_DIM)
NEG_INF = -1e30
D_FF = 2816
CONV_WIDTH = 3
RMS_EPS = 1e-6

kernel_name = "yoco_pool_swa_sink_hybrid"


def rms_norm(x, g):
    xf = x.astype(jnp.float32)
    y = xf * lax.rsqrt(jnp.mean(xf * xf, axis=-1, keepdims=True) + RMS_EPS)
    return (y * g.astype(jnp.float32)).astype(x.dtype)


def pool_mixer(h, w_pool, scale):
    B, S, D = h.shape
    hf = h.astype(jnp.float32)
    csum = jnp.concatenate([jnp.zeros((B, 1, D), jnp.float32), jnp.cumsum(hf, axis=1)], axis=1)
    t = jnp.arange(1, S + 1)
    diffs = []
    for gi, w in enumerate(POOL_WINDOWS):
        sl = slice(gi * GROUP_CH, (gi + 1) * GROUP_CH)
        lo = jnp.maximum(t - w, 0)
        cnt = jnp.minimum(t, w).astype(jnp.float32)
        mean = (csum[:, 1:, sl] - csum[:, lo, sl]) / cnt[None, :, None]
        diffs.append(mean - hf[..., sl])
    d = jnp.stack(diffs, axis=2).astype(h.dtype)
    y = jnp.einsum('bsgc,gcd->bsgd', d, w_pool).reshape(B, S, D)
    return y * scale


def conv_glu_ffn(h, w_in, conv_w, conv_b, w_out):
    S = h.shape[1]
    u = h @ w_in
    up = jnp.pad(u, ((0, 0), (CONV_WIDTH - 1, 0), (0, 0)))
    u = sum(conv_w[k] * up[:, k:k + S] for k in range(CONV_WIDTH)) + conv_b
    gate, val = jnp.split(u, 2, axis=-1)
    return (jax.nn.gelu(gate, approximate=True) * val) @ w_out


def rope(x, cos, sin):
    xf = x.astype(jnp.float32)
    x1, x2 = jnp.split(xf, 2, axis=-1)
    return jnp.concatenate([x1 * cos - x2 * sin, x2 * cos + x1 * sin], axis=-1).astype(x.dtype)


def rope_tables(positions):
    inv_freq = 1.0 / (ROPE_THETA ** (jnp.arange(0, HEAD_DIM, 2, dtype=jnp.float32) / HEAD_DIM))
    ang = positions.astype(jnp.float32)[..., None] * inv_freq
    return jnp.cos(ang)[:, :, None, :], jnp.sin(ang)[:, :, None, :]


def band_blocks(t):
    B, S = t.shape[:2]
    nb = S // BLOCK
    tb = t.reshape(B, nb, BLOCK, N_KV_HEADS, HEAD_DIM)
    prev = jnp.pad(tb, ((0, 0), (1, 0), (0, 0), (0, 0), (0, 0)))[:, :-1]
    return jnp.concatenate([prev, tb], axis=2).astype(jnp.float32)


def swa_sink_attention(q, kk, vv, sinks):
    B, S = q.shape[:2]
    nb = S // BLOCK
    qb = q.reshape(B, nb, BLOCK, N_KV_HEADS, Q_PER_KV, HEAD_DIM).astype(jnp.float32) * ATTN_SCALE
    s = jnp.einsum('bnqhgd,bnkhd->bnhgqk', qb, kk)
    qi = jnp.arange(BLOCK)[:, None]
    kj = jnp.arange(2 * BLOCK)[None, :]
    rel = BLOCK + qi - kj
    blk = jnp.arange(nb)[:, None, None]
    valid = (rel >= 0) & (rel < WINDOW) & (blk * BLOCK + kj - BLOCK >= 0)
    s = jnp.where(valid[None, :, None, None], s, NEG_INF)
    sink = sinks.astype(jnp.float32).reshape(N_KV_HEADS, Q_PER_KV)[None, None, :, :, None, None]
    m = jnp.maximum(jnp.max(s, axis=-1, keepdims=True), sink)
    p = jnp.exp(s - m)
    denom = jnp.sum(p, axis=-1) + jnp.exp(sink - m)[..., 0]
    o = jnp.einsum('bnhgqk,bnkhd->bnhgqd', p, vv) / denom[..., None]
    o = o.transpose(0, 1, 4, 2, 3, 5).reshape(B, S, N_Q_HEADS * HEAD_DIM)
    return o.astype(q.dtype)


def setup_inputs(seed: int = 0) -> dict:
    key = jax.random.key(seed)
    ks = jax.random.split(key, 20)
    f32 = jnp.float32
    D, F = D_MODEL, D_FF
    HQD, HKVD = N_Q_HEADS * HEAD_DIM, N_KV_HEADS * HEAD_DIM

    def gain(k, shape):
        return 1.0 + 0.05 * jax.random.normal(k, shape, f32)

    x = jax.random.normal(ks[0], (BATCH, SEQ, D), f32)
    positions = jnp.broadcast_to(jnp.arange(SEQ, dtype=jnp.int32)[None, :], (BATCH, SEQ))
    return {
        "x": x,
        "positions": positions,
        "mix_pre_g": gain(ks[1], (DEPTH, D)),
        "mix_post_g": gain(ks[2], (DEPTH, D)),
        "pool_w": jax.random.normal(ks[3], (N_A, N_POOL_GROUPS, GROUP_CH, GROUP_CH), f32) * GROUP_CH ** -0.5,
        "pool_scale": 1.0 + 0.1 * jax.random.normal(ks[4], (N_A, D), f32),
        "kv_norm_g": gain(ks[5], (D,)),
        "w_kv": jax.random.normal(ks[6], (D, 2 * HKVD), f32) * D ** -0.5,
        "w_q": jax.random.normal(ks[7], (N_B, D, HQD), f32) * D ** -0.5,
        "w_o": jax.random.normal(ks[8], (N_B, HQD, D), f32) * HQD ** -0.5,
        "sinks": jax.random.normal(ks[9], (N_B, N_Q_HEADS), f32),
        "ffn_pre_g": gain(ks[10], (DEPTH, D)),
        "ffn_post_g": gain(ks[11], (DEPTH, D)),
        "ffn_w_in": jax.random.normal(ks[12], (DEPTH, D, 2 * F), f32) * D ** -0.5,
        "ffn_conv_w": jax.random.normal(ks[13], (DEPTH, CONV_WIDTH, 2 * F), f32) * CONV_WIDTH ** -0.5,
        "ffn_conv_b": 0.01 * jax.random.normal(ks[14], (DEPTH, 2 * F), f32),
        "ffn_w_out": jax.random.normal(ks[15], (DEPTH, F, D), f32) * F ** -0.5,
    }


def reference(x, positions, mix_pre_g, mix_post_g, pool_w, pool_scale, kv_norm_g, w_kv,
              w_q, w_o, sinks, ffn_pre_g, ffn_post_g, ffn_w_in, ffn_conv_w, ffn_conv_b, ffn_w_out):
    B, S, D = x.shape
    cos, sin = rope_tables(positions)
    kk = vv = None
    for layer in range(DEPTH):
        h = rms_norm(x, mix_pre_g[layer])
        if layer < N_A:
            m = pool_mixer(h, pool_w[layer], pool_scale[layer])
        else:
            if layer == N_A:
                hkv = rms_norm(x, kv_norm_g)
                kv = (hkv @ w_kv).reshape(B, S, 2, N_KV_HEADS, HEAD_DIM)
                k_shared = rope(kv[:, :, 0], cos, sin)
                kk, vv = band_blocks(k_shared), band_blocks(kv[:, :, 1])
            j = layer - N_A
            q = rope((h @ w_q[j]).reshape(B, S, N_Q_HEADS, HEAD_DIM), cos, sin)
            m = swa_sink_attention(q, kk, vv, sinks[j]) @ w_o[j]
        x = x + rms_norm(m, mix_post_g[layer])
        f = conv_glu_ffn(rms_norm(x, ffn_pre_g[layer]), ffn_w_in[layer], ffn_conv_w[layer],
                         ffn_conv_b[layer], ffn_w_out[layer])
        x = x + rms_norm(f, ffn_post_g[layer])
    return x
```

```cpp
#include <hip/hip_runtime.h>
#include <hip/hip_cooperative_groups.h>
#include <cstdio>
#include <cstdint>
#include <cmath>
namespace cg = cooperative_groups;

#define LAS __attribute__((address_space(3)))
#define PG8_LAS LAS
typedef unsigned short bf16_t;
typedef short bf16x8 __attribute__((ext_vector_type(8)));
typedef float f32x4 __attribute__((ext_vector_type(4)));
typedef float f32x16 __attribute__((ext_vector_type(16)));
typedef unsigned u32x4 __attribute__((ext_vector_type(4)));
typedef unsigned u32x2 __attribute__((ext_vector_type(2)));
typedef float f32x2_t __attribute__((ext_vector_type(2)));
typedef __bf16 bf16x2_t __attribute__((ext_vector_type(2)));

constexpr int D = 1024, BATCH = 8, SEQ = 4096, M = BATCH * SEQ, DEPTH = 4, NA = 2, FF = 2816, FF2 = 5632;
constexpr int HD = 64, NQH = 16, NKVH = 4, NQKV = 1536;
constexpr float RMS_EPS = 1e-6f;
constexpr float LOG2E = 1.4426950408889634f;

__device__ __forceinline__ unsigned pk2(float lo, float hi) { f32x2_t v = {lo, hi}; bf16x2_t b = __builtin_convertvector(v, bf16x2_t); return __builtin_bit_cast(unsigned, b); }
__device__ __forceinline__ float bf_lo(unsigned u) { return __builtin_bit_cast(float, u << 16); }
__device__ __forceinline__ float bf_hi(unsigned u) { return __builtin_bit_cast(float, u & 0xffff0000u); }
template <int CTRL> __device__ __forceinline__ float dppf(float old, float src) {
    return __builtin_bit_cast(float, __builtin_amdgcn_update_dpp(__builtin_bit_cast(int, old), __builtin_bit_cast(int, src), CTRL, 0xf, 0xf, false));
}
constexpr int DPP_SHR1 = 0x111, DPP_SHR2 = 0x112, DPP_ROR1 = 0x121, DPP_ROR2 = 0x122;
__device__ __forceinline__ float gelu_tanh(float x) {
    const float c1 = -2.0f * 0.7978845608028654f * LOG2E, c2 = c1 * 0.044715f;
    const float t = x * (c1 + c2 * x * x);
    const float e = __builtin_amdgcn_exp2f(t);
    return x * __builtin_amdgcn_rcpf(1.0f + e);
}

namespace pg8 {
constexpr int BM = 256, BK = 64, HALF = 128, HTB = HALF * BK * 2  , STAGE_BYTES = 8 * HTB, NXCD = 8, WGM = 8;
__host__ __device__ __forceinline__ int lds_byte(int r, int c) { const int st = (r >> 4) * 2 + (c >> 5), rr = r & 15, cc = c & 31, ob = rr * 64 + cc * 2; return st * 1024 + (ob ^ (((ob >> 9) & 1) << 5)); }
__host__ __device__ __forceinline__ void stage_rc(int b, int& R, int& C) { const int st = b / 1024, sb = b % 1024, swz = sb ^ (((sb >> 9) & 1) << 5); R = (st >> 1) * 16 + swz / 64; C = (st & 1) * 32 + (swz % 64) / 2; }
__host__ __device__ __forceinline__ int perm32(int rho) { const int n = rho >> 4, i = rho & 15; return 8 * (i >> 2) + 4 * n + (i & 3); }

struct Unit { int pm, pn; };
struct Gemm { const bf16_t* A; const bf16_t* Bt; int lda, ldb, K, acol; };

struct StaticOrder {
    int nM, nN, nwg, G, c;
    __host__ __device__ void init(int M_, int N_, int G_, int c_) { nM = M_ / BM; nN = N_ / BM; nwg = nM * nN; G = G_; c = c_; }
    __host__ __device__ bool next(int i, Unit& u) const {
        const long L = (long)i * G + c; if (L >= nwg) return false;
        int wgid = (int)L; { const int q = nwg / NXCD, r = nwg % NXCD, xcd = wgid % NXCD, off = wgid / NXCD; wgid = (xcd < r ? xcd * (q + 1) : r * (q + 1) + (xcd - r) * q) + off; }
        const int nig = WGM * nN, gid = wgid / nig, fm = gid * WGM, gsz = (nM - fm) < WGM ? (nM - fm) : WGM;
        u.pm = fm + ((wgid % nig) % gsz); u.pn = (wgid % nig) / gsz; return true;
    }
    __device__ __forceinline__ void a_ready(const Unit&) const {}
    __device__ __forceinline__ void done(const Unit&) const {}
};

struct EpiBf16 {
    static constexpr bool PERM = true, AFTER_DRAIN = false;
    bf16_t* O; int ldc;
    __device__ __forceinline__ void operator()(f32x4 (&acc)[2][2][4][2], const Unit& u, int wr, int wc, int fr, int fq, LAS unsigned char*) const {
        const int row0 = u.pm * BM + wr * 64 + fr, col0 = u.pn * BM + wc * 32 + 8 * fq;
#pragma unroll
        for (int ai = 0; ai < 2; ++ai)
#pragma unroll
            for (int m = 0; m < 4; ++m) { bf16_t* rowp = O + (size_t)(row0 + ai * HALF + m * 16) * ldc + col0;
#pragma unroll
                for (int bj = 0; bj < 2; ++bj) { const f32x4 v0 = acc[ai][bj][m][0], v1 = acc[ai][bj][m][1];
                    u32x4 w; w.x = pk2(v0[0], v0[1]); w.y = pk2(v0[2], v0[3]); w.z = pk2(v1[0], v1[1]); w.w = pk2(v1[2], v1[3]);
                    *(u32x4*)(rowp + bj * HALF) = w; } }
    }
};

struct EpiQKV {
    static constexpr bool PERM = true, AFTER_DRAIN = false;
    bf16_t* Q; bf16_t* Kb; bf16_t* Vt; const float* cs; const float* sn;
    __device__ __forceinline__ void operator()(f32x4 (&acc)[2][2][4][2], const Unit& u, int wr, int wc, int fr, int fq, LAS unsigned char*) const {
        if (u.pn <= 4) {
            bf16_t* base; int ld, head;
            if (u.pn < 4) { base = Q; ld = D; head = u.pn * 4 + wc; } else { base = Kb; ld = 256; head = wc; }
#pragma unroll
            for (int ai = 0; ai < 2; ++ai)
#pragma unroll
                for (int m = 0; m < 4; ++m) {
                    const int row = u.pm * BM + ai * HALF + wr * 64 + m * 16 + fr;
                    const float* cp = cs + (size_t)row * 32 + 8 * fq; const float* sp = sn + (size_t)row * 32 + 8 * fq;
                    u32x4 w1, w2;
#pragma unroll
                    for (int n = 0; n < 2; ++n) {
                        const f32x4 c = *(const f32x4*)(cp + 4 * n), s = *(const f32x4*)(sp + 4 * n);
                        const f32x4 x1 = acc[ai][0][m][n], x2 = acc[ai][1][m][n];
                        const f32x4 o1 = x1 * c - x2 * s, o2 = x2 * c + x1 * s;
                        if (n == 0) { w1.x = pk2(o1[0], o1[1]); w1.y = pk2(o1[2], o1[3]); w2.x = pk2(o2[0], o2[1]); w2.y = pk2(o2[2], o2[3]); }
                        else        { w1.z = pk2(o1[0], o1[1]); w1.w = pk2(o1[2], o1[3]); w2.z = pk2(o2[0], o2[1]); w2.w = pk2(o2[2], o2[3]); }
                    }
                    bf16_t* op = base + (size_t)row * ld + head * 64 + 8 * fq;
                    *(u32x4*)op = w1; *(u32x4*)(op + 32) = w2;
                }
        } else {
            const int pos = (fr & 3) + 4 * ((fr >> 3) & 1) + 8 * ((fr >> 2) & 1);
#pragma unroll
            for (int ai = 0; ai < 2; ++ai)
#pragma unroll
                for (int m = 0; m < 4; ++m) {
                    const int row = u.pm * BM + ai * HALF + wr * 64 + m * 16;
                    const int b = row >> 12, s = (row & 4095) + pos;
#pragma unroll
                    for (int bj = 0; bj < 2; ++bj)
#pragma unroll
                        for (int n = 0; n < 2; ++n)
#pragma unroll
                            for (int e = 0; e < 4; ++e) {
                                const int c = bj * HALF + wc * 32 + 8 * fq + 4 * n + e, hk = c >> 6, d = c & 63;
                                Vt[((size_t)((b * NKVH + hk) * HD + d)) * SEQ + s] = (bf16_t)(pk2(acc[ai][bj][m][n][e], 0.f) & 0xffffu);
                            }
                }
        }
    }
};

struct EpiGlu {
    static constexpr bool PERM = true, AFTER_DRAIN = false;
    bf16_t* Aout; const float* cw; const float* cb; float* side;
    __device__ __forceinline__ void operator()(f32x4 (&acc)[2][2][4][2], const Unit& u, int wr, int wc, int fr, int fq, LAS unsigned char* xl) const {
        LAS f32x4* X = (LAS f32x4*)xl;
        const int tc0 = wc * 32 + 8 * fq;
        if (fr >= 14) {
#pragma unroll
            for (int ai = 0; ai < 2; ++ai)
#pragma unroll
                for (int bj = 0; bj < 2; ++bj)
#pragma unroll
                    for (int n = 0; n < 2; ++n) X[((ai * 2 + wr) * 2 + (fr - 14)) * 64 + ((bj * HALF + tc0 + 4 * n) >> 2)] = acc[ai][bj][3][n];
        }
        if (wr == 0 && fr < 2) {
#pragma unroll
            for (int bj = 0; bj < 2; ++bj)
#pragma unroll
                for (int n = 0; n < 2; ++n) *(f32x4*)(side + ((size_t)(u.pm * 4 + fr)) * FF2 + u.pn * 256 + bj * HALF + tc0 + 4 * n) = acc[0][bj][0][n];
        }
        if (wr == 1 && fr >= 14) {
#pragma unroll
            for (int bj = 0; bj < 2; ++bj)
#pragma unroll
                for (int n = 0; n < 2; ++n) *(f32x4*)(side + ((size_t)(u.pm * 4 + 2 + (fr - 14))) * FF2 + u.pn * 256 + bj * HALF + tc0 + 4 * n) = acc[1][bj][3][n];
        }
        asm volatile("s_waitcnt lgkmcnt(0)" ::: "memory"); __builtin_amdgcn_s_barrier(); asm volatile("" ::: "memory");
        const int row0 = u.pm * BM + wr * 64 + fr;
#pragma unroll
        for (int n = 0; n < 2; ++n) {
            const int c0 = u.pn * 128 + tc0 + 4 * n;
            const f32x4 wg0 = *(const f32x4*)(cw + c0), wg1 = *(const f32x4*)(cw + FF2 + c0), wg2 = *(const f32x4*)(cw + 2 * FF2 + c0), bg = *(const f32x4*)(cb + c0);
            const f32x4 wv0 = *(const f32x4*)(cw + FF + c0), wv1 = *(const f32x4*)(cw + FF2 + FF + c0), wv2 = *(const f32x4*)(cw + 2 * FF2 + FF + c0), bv = *(const f32x4*)(cb + FF + c0);
#pragma unroll
            for (int ai = 0; ai < 2; ++ai) {
                const int sidx = ai * 2 + wr;
                f32x4 hg = (f32x4){0.f, 0.f, 0.f, 0.f}, hv = hg;
                if (sidx > 0) { hg = X[((sidx - 1) * 2 + (fr & 1)) * 64 + ((tc0 + 4 * n) >> 2)]; hv = X[((sidx - 1) * 2 + (fr & 1)) * 64 + ((HALF + tc0 + 4 * n) >> 2)]; }
                f32x4 p1g, p2g, p1v, p2v;
#pragma unroll
                for (int e = 0; e < 4; ++e) { p1g[e] = dppf<DPP_ROR1>(hg[e], hg[e]); p2g[e] = dppf<DPP_ROR2>(hg[e], hg[e]); p1v[e] = dppf<DPP_ROR1>(hv[e], hv[e]); p2v[e] = dppf<DPP_ROR2>(hv[e], hv[e]); }
#pragma unroll
                for (int m = 0; m < 4; ++m) {
                    const f32x4 g = acc[ai][0][m][n], v = acc[ai][1][m][n];
                    f32x4 o;
#pragma unroll
                    for (int e = 0; e < 4; ++e) {
                        const float g1 = dppf<DPP_SHR1>(p1g[e], g[e]), g2 = dppf<DPP_SHR2>(p2g[e], g[e]);
                        const float v1 = dppf<DPP_SHR1>(p1v[e], v[e]), v2 = dppf<DPP_SHR2>(p2v[e], v[e]);
                        p1g[e] = dppf<DPP_ROR1>(g[e], g[e]); p2g[e] = dppf<DPP_ROR2>(g[e], g[e]);
                        p1v[e] = dppf<DPP_ROR1>(v[e], v[e]); p2v[e] = dppf<DPP_ROR2>(v[e], v[e]);
                        const float cgv = wg2[e] * g[e] + wg1[e] * g1 + wg0[e] * g2 + bg[e];
                        const float cvv = wv2[e] * v[e] + wv1[e] * v1 + wv0[e] * v2 + bv[e];
                        o[e] = gelu_tanh(cgv) * cvv;
                    }
                    u32x2 w; w.x = pk2(o[0], o[1]); w.y = pk2(o[2], o[3]);
                    *(u32x2*)(Aout + (size_t)(row0 + ai * HALF + m * 16) * FF + u.pn * 128 + tc0 + 4 * n) = w;
                }
                __builtin_amdgcn_sched_barrier(0);
            }
        }
    }
};

template <class Epi, class Sched, bool ALIGN_EPI = false, bool SP2 = false>
__device__ __forceinline__ void gemm_phase(PG8_LAS unsigned char* lds, const Gemm g, const Sched& S, const Epi& E, const int tid) {
    const int wid = __builtin_amdgcn_readfirstlane(tid >> 6), lane = tid & 63, wr = wid >> 2, wc = wid & 3, fr = lane & 15, fq = lane >> 4;
    const int K = g.K, nt = K / BK;
    unsigned voffA[2], voffB[2];
#pragma unroll
    for (int i = 0; i < 2; ++i) { int R, C; stage_rc(tid * 16 + i * 8192, R, C); const int Rb = Epi::PERM ? ((R & ~31) + perm32(R & 31)) : R;
        voffA[i] = (unsigned)(R * g.lda + C) * 2u; voffB[i] = (unsigned)(Rb * g.ldb + C) * 2u; }
    const size_t kstep = (size_t)(BK * 2);
    const size_t hstepA = (size_t)HALF * g.lda * 2, hstepB = (size_t)HALF * g.ldb * 2;
    const size_t tstepA = 2 * hstepA, tstepB = 2 * hstepB;
    const unsigned ldsw = (unsigned)wid * 1024u;
    const int aoff = lds_byte(wr * 64 + fr, fq * 8), boff = lds_byte(wc * 32 + fr, fq * 8);
#define PG8_SA(b, h) (((b) * 2 + (h)) * HTB)
#define PG8_SB(b, h) ((4 + (b) * 2 + (h)) * HTB)
#define PG8_STAGE(bufoff, gbase, voff) do { _Pragma("unroll") for (int _i = 0; _i < 2; ++_i) \
        __builtin_amdgcn_global_load_lds((const unsigned*)((const char*)(gbase) + (voff)[_i]), (PG8_LAS unsigned*)(lds + (bufoff) + ldsw + _i * 8192), 16, 0, 0); } while (0)
#define PG8_LDA(dst, b, h) do { _Pragma("unroll") for (int m = 0; m < 4; ++m) _Pragma("unroll") for (int k = 0; k < 2; ++k) dst[m][k] = *(const PG8_LAS bf16x8*)(lds + PG8_SA(b, h) + aoff + m * 2048 + k * 1024); } while (0)
#define PG8_LDB(dst, b, h) do { _Pragma("unroll") for (int n = 0; n < 2; ++n) _Pragma("unroll") for (int k = 0; k < 2; ++k) dst[n][k] = *(const PG8_LAS bf16x8*)(lds + PG8_SB(b, h) + boff + n * 2048 + k * 1024); } while (0)
#define PG8_MMA(ai, bj, At, Bt) do { __builtin_amdgcn_s_setprio(1); _Pragma("unroll") for (int m = 0; m < 4; ++m) _Pragma("unroll") for (int n = 0; n < 2; ++n) _Pragma("unroll") for (int k = 0; k < 2; ++k) \
        acc[ai][bj][m][n] = __builtin_amdgcn_mfma_f32_16x16x32_bf16(Bt[n][k], At[m][k], acc[ai][bj][m][n], 0, 0, 0); __builtin_amdgcn_s_setprio(0); } while (0)
#define PG8_WAIT_V(n) asm volatile("s_waitcnt vmcnt(" #n ")" ::: "memory")
#define PG8_WAIT_L(n) asm volatile("s_waitcnt lgkmcnt(" #n ")" ::: "memory")
#define PG8_BAR __builtin_amdgcn_s_barrier()
#define PG8_SCHED __builtin_amdgcn_sched_barrier(0)
    Unit cur, nxt; int ui = 0;
    if (!S.next(0, cur)) return;
    f32x4 acc[2][2][4][2];
#pragma unroll
    for (int a = 0; a < 2; ++a)
#pragma unroll
        for (int b = 0; b < 2; ++b)
#pragma unroll
            for (int m = 0; m < 4; ++m)
#pragma unroll
                for (int n = 0; n < 2; ++n) acc[a][b][m][n] = (f32x4){0.f, 0.f, 0.f, 0.f};
    bf16x8 At[4][2], B0[2][2], B1[2][2];
    const char* cA = (const char*)g.A + (size_t)cur.pm * tstepA + (size_t)cur.pn * g.acol * 2; const char* cB = (const char*)g.Bt + (size_t)cur.pn * tstepB;
    S.a_ready(cur);
    if constexpr (SP2) {
        PG8_STAGE(PG8_SB(0, 0), cB, voffB); PG8_STAGE(PG8_SB(0, 1), cB + hstepB, voffB); PG8_STAGE(PG8_SA(0, 0), cA, voffA); PG8_STAGE(PG8_SA(0, 1), cA + hstepA, voffA);
        if (wr == 1) PG8_BAR;
        PG8_WAIT_V(2); PG8_BAR;
        PG8_STAGE(PG8_SB(1, 0), cB + kstep, voffB); PG8_STAGE(PG8_SA(1, 0), cA + kstep, voffA); PG8_STAGE(PG8_SB(1, 1), cB + hstepB + kstep, voffB);
        PG8_WAIT_V(6); PG8_BAR;
    } else {
        PG8_STAGE(PG8_SB(0, 0), cB, voffB); PG8_STAGE(PG8_SA(0, 0), cA, voffA); PG8_STAGE(PG8_SB(0, 1), cB + hstepB, voffB); PG8_STAGE(PG8_SA(0, 1), cA + hstepA, voffA);
        if (wr == 1) PG8_BAR;
        PG8_WAIT_V(4); PG8_BAR;
        PG8_STAGE(PG8_SB(1, 0), cB + kstep, voffB); PG8_STAGE(PG8_SA(1, 0), cA + kstep, voffA); PG8_STAGE(PG8_SB(1, 1), cB + hstepB + kstep, voffB);
        PG8_WAIT_V(6); PG8_BAR;
    }
    for (;;) {
        const bool has_next = S.next(ui + 1, nxt);
        const char* nA = has_next ? (const char*)g.A + (size_t)nxt.pm * tstepA + (size_t)nxt.pn * g.acol * 2 : cA; const char* nB = has_next ? (const char*)g.Bt + (size_t)nxt.pn * tstepB : cB;
        for (int t = 0; t < nt; t += 2) {
            const bool last = (t == nt - 2);
            const char* a1 = cA + (size_t)(t + 1) * kstep;
            const char* a2 = last ? nA : cA + (size_t)(t + 2) * kstep; const char* b2 = last ? nB : cB + (size_t)(t + 2) * kstep;
            const char* a3 = a2 + kstep; const char* b3 = b2 + kstep;
            if (last && has_next) S.a_ready(nxt);
            if constexpr (SP2) {
            PG8_LDB(B0, 0, 0); PG8_LDB(B1, 0, 1); PG8_SCHED; PG8_LDA(At, 0, 0); PG8_STAGE(PG8_SA(1, 1), a1 + hstepA, voffA);
            PG8_WAIT_V(8); PG8_WAIT_L(0); PG8_BAR; PG8_MMA(0, 0, At, B0); PG8_MMA(0, 1, At, B1); PG8_BAR; PG8_SCHED;
            PG8_LDA(At, 0, 1); PG8_STAGE(PG8_SB(0, 0), b2, voffB); PG8_STAGE(PG8_SB(0, 1), b2 + hstepB, voffB); PG8_STAGE(PG8_SA(0, 0), a2, voffA);
            PG8_WAIT_V(8); PG8_WAIT_L(0); PG8_BAR; PG8_MMA(1, 0, At, B0); PG8_MMA(1, 1, At, B1); PG8_BAR; PG8_SCHED;
            PG8_LDB(B0, 1, 0); PG8_LDB(B1, 1, 1); PG8_SCHED; PG8_LDA(At, 1, 0); PG8_STAGE(PG8_SA(0, 1), a2 + hstepA, voffA);
            PG8_WAIT_V(8); PG8_WAIT_L(0); PG8_BAR; PG8_MMA(0, 0, At, B0); PG8_MMA(0, 1, At, B1); PG8_BAR; PG8_SCHED;
            PG8_LDA(At, 1, 1); PG8_STAGE(PG8_SB(1, 0), b3, voffB); PG8_STAGE(PG8_SB(1, 1), b3 + hstepB, voffB); PG8_STAGE(PG8_SA(1, 0), a3, voffA);
            PG8_WAIT_V(8); PG8_WAIT_L(0); PG8_BAR; PG8_MMA(1, 0, At, B0); PG8_MMA(1, 1, At, B1); PG8_BAR; PG8_SCHED;
            } else {
            PG8_LDB(B0, 0, 0); PG8_SCHED; PG8_LDA(At, 0, 0); PG8_STAGE(PG8_SA(1, 1), a1 + hstepA, voffA);
            PG8_WAIT_L(8); PG8_BAR; PG8_WAIT_L(0); PG8_MMA(0, 0, At, B0); PG8_BAR; PG8_SCHED;
            PG8_LDB(B1, 0, 1); PG8_STAGE(PG8_SB(0, 0), b2, voffB);
            PG8_BAR; PG8_WAIT_L(0); PG8_MMA(0, 1, At, B1); PG8_BAR;
            PG8_LDA(At, 0, 1); PG8_STAGE(PG8_SA(0, 0), a2, voffA);
            PG8_BAR; PG8_WAIT_L(0); PG8_MMA(1, 0, At, B0); PG8_BAR; PG8_SCHED;
            PG8_STAGE(PG8_SB(0, 1), b2 + hstepB, voffB);
            PG8_WAIT_V(6); PG8_BAR; PG8_MMA(1, 1, At, B1); PG8_BAR;
            PG8_LDB(B0, 1, 0); PG8_SCHED; PG8_LDA(At, 1, 0); PG8_STAGE(PG8_SA(0, 1), a2 + hstepA, voffA);
            PG8_WAIT_L(8); PG8_BAR; PG8_WAIT_L(0); PG8_MMA(0, 0, At, B0); PG8_BAR; PG8_SCHED;
            PG8_LDB(B1, 1, 1); PG8_STAGE(PG8_SB(1, 0), b3, voffB);
            PG8_BAR; PG8_WAIT_L(0); PG8_MMA(0, 1, At, B1); PG8_BAR;
            PG8_LDA(At, 1, 1); PG8_STAGE(PG8_SA(1, 0), a3, voffA);
            PG8_BAR; PG8_WAIT_L(0); PG8_MMA(1, 0, At, B0); PG8_BAR; PG8_SCHED;
            PG8_STAGE(PG8_SB(1, 1), b3 + hstepB, voffB);
            PG8_WAIT_V(6); PG8_BAR; PG8_MMA(1, 1, At, B1); PG8_BAR;
            }
        }
        if constexpr (ALIGN_EPI) { if (wr == 0) PG8_BAR; }
        if constexpr (!Epi::AFTER_DRAIN) { E(acc, cur, wr, wc, fr, fq, lds + STAGE_BYTES); S.done(cur); }
        if (!has_next) break;
#pragma unroll
        for (int a = 0; a < 2; ++a)
#pragma unroll
            for (int b = 0; b < 2; ++b)
#pragma unroll
                for (int m = 0; m < 4; ++m)
#pragma unroll
                    for (int n = 0; n < 2; ++n) acc[a][b][m][n] = (f32x4){0.f, 0.f, 0.f, 0.f};
        cur = nxt; cA = nA; cB = nB; ++ui;
        if constexpr (ALIGN_EPI) { if (wr == 1) PG8_BAR; }
    }
    PG8_WAIT_V(0);
    if constexpr (!ALIGN_EPI) { if (wr == 0) PG8_BAR; }
    PG8_BAR;
    if constexpr (Epi::AFTER_DRAIN) { E.fused(acc, cur, wr, wc, fr, fq, lds, wid, lane); S.done(cur); }
#undef PG8_SA
#undef PG8_SB
#undef PG8_STAGE
#undef PG8_LDA
#undef PG8_LDB
#undef PG8_MMA
#undef PG8_WAIT_V
#undef PG8_WAIT_L
#undef PG8_BAR
#undef PG8_SCHED
}
}

constexpr size_t MiB = 1u << 20;
constexpr size_t WS_BT1 = 0;
constexpr size_t WS_BT2 = 44 * MiB;
constexpr size_t WS_BTQKV = 66 * MiB;
constexpr size_t WS_BTO = 71 * MiB;
constexpr size_t WS_BTP = 75 * MiB;
constexpr size_t WS_COS = 76 * MiB, WS_SIN = 80 * MiB;
constexpr size_t WS_SIDE = 84 * MiB;
constexpr size_t WS_XN = 96 * MiB;
constexpr size_t WS_T = 160 * MiB;
constexpr size_t WS_K = 224 * MiB, WS_VT = 240 * MiB;
constexpr size_t WS_A = 256 * MiB;
constexpr size_t WS_END = 432 * MiB;

constexpr int LDS_BYTES = 147456;
constexpr int NWAVES = 8;

struct Args {
    const float* x; const int* positions; const float* mix_pre_g; const float* mix_post_g; const float* pool_w; const float* pool_scale;
    const float* kv_norm_g; const float* w_kv; const float* w_q; const float* w_o; const float* sinks; const float* ffn_pre_g; const float* ffn_post_g;
    const float* ffn_w_in; const float* ffn_conv_w; const float* ffn_conv_b; const float* ffn_w_out;
    float* out; unsigned char* ws;
    float inv_freq[32];
    int ph_lo, ph_hi;
};

__device__ __forceinline__ float wave_sum(float v) {
#pragma unroll
    for (int o = 1; o < 64; o <<= 1) v += __shfl_xor(v, o);
    return v;
}

__device__ __forceinline__ void transpose_item(const float* W, int ldw, int k0, int n0, bf16_t* WT, int ldo, int orow0, const float* gk, const float* gn, float cst, LAS float* scr, int lane) {
#pragma unroll 8
    for (int i = 0; i < 32; ++i) { const int kk = 2 * i + (lane >> 5); float v = W[(size_t)(k0 + kk) * ldw + n0 + (lane & 31)]; if (gk) v *= gk[k0 + kk]; scr[kk * 33 + (lane & 31)] = v; }
    asm volatile("s_waitcnt lgkmcnt(0)" ::: "memory");
    const int c = lane & 7;
#pragma unroll
    for (int j = 0; j < 4; ++j) { const int n = (lane >> 3) + 8 * j; const LAS float* s = scr + (8 * c) * 33 + n;
        const float gg = (gn ? gn[n0 + n] : 1.0f) * cst;
        u32x4 o; o.x = pk2(s[0 * 33] * gg, s[1 * 33] * gg); o.y = pk2(s[2 * 33] * gg, s[3 * 33] * gg); o.z = pk2(s[4 * 33] * gg, s[5 * 33] * gg); o.w = pk2(s[6 * 33] * gg, s[7 * 33] * gg);
        *(u32x4*)(WT + (size_t)(orow0 + n) * ldo + k0 + 8 * c) = o; }
    asm volatile("s_waitcnt lgkmcnt(0)" ::: "memory");
}

__device__ __forceinline__ void row_phase(const float* xsrc, const bf16_t* t, const float* g, float* xdst, bf16_t* xn, int gw, int NGW, int lane) {
    f32x4 gv[4];
#pragma unroll
    for (int j = 0; j < 4; ++j) gv[j] = g ? *(const f32x4*)(g + 4 * lane + 256 * j) : (f32x4){0.f, 0.f, 0.f, 0.f};
    for (int m = gw; m < M; m += NGW) {
        f32x4 xv[4];
#pragma unroll
        for (int j = 0; j < 4; ++j) xv[j] = *(const f32x4*)(xsrc + (size_t)m * D + 4 * lane + 256 * j);
        if (t) {
            f32x4 tv[4]; float ss = 0.f;
#pragma unroll
            for (int j = 0; j < 4; ++j) { const u32x2 w = *(const u32x2*)(t + (size_t)m * D + 4 * lane + 256 * j);
                tv[j] = (f32x4){bf_lo(w.x), bf_hi(w.x), bf_lo(w.y), bf_hi(w.y)}; ss += (tv[j][0] * tv[j][0] + tv[j][1] * tv[j][1]) + (tv[j][2] * tv[j][2] + tv[j][3] * tv[j][3]); }
            const float rs = 1.0f / sqrtf(wave_sum(ss) * (1.0f / D) + RMS_EPS);
#pragma unroll
            for (int j = 0; j < 4; ++j) xv[j] += tv[j] * rs * gv[j];
        }
        if (xdst) {
#pragma unroll
            for (int j = 0; j < 4; ++j) *(f32x4*)(xdst + (size_t)m * D + 4 * lane + 256 * j) = xv[j];
        }
        if (xn) {
            float s2 = 0.f;
#pragma unroll
            for (int j = 0; j < 4; ++j) s2 += (xv[j][0] * xv[j][0] + xv[j][1] * xv[j][1]) + (xv[j][2] * xv[j][2] + xv[j][3] * xv[j][3]);
            const float r2 = 1.0f / sqrtf(wave_sum(s2) * (1.0f / D) + RMS_EPS);
#pragma unroll
            for (int j = 0; j < 4; ++j) { u32x2 w; w.x = pk2(xv[j][0] * r2, xv[j][1] * r2); w.y = pk2(xv[j][2] * r2, xv[j][3] * r2); *(u32x2*)(xn + (size_t)m * D + 4 * lane + 256 * j) = w; }
        }
    }
}

__device__ __forceinline__ void diff_phase(const bf16_t* xn, bf16_t* dd, int gw, int NGW, int lane) {
    for (int task = gw; task < (M / 2) * 4; task += NGW) {
        const int grp = task & 3, row = (task >> 2) * 2 + (lane >> 5), ts = row & (SEQ - 1), w = 2 << grp;
        const size_t off = (size_t)row * D + grp * 256 + 8 * (lane & 31);
        const u32x4 cur = *(const u32x4*)(xn + off);
        float acc[8] = {bf_lo(cur.x), bf_hi(cur.x), bf_lo(cur.y), bf_hi(cur.y), bf_lo(cur.z), bf_hi(cur.z), bf_lo(cur.w), bf_hi(cur.w)};
        float c0[8];
#pragma unroll
        for (int e = 0; e < 8; ++e) c0[e] = acc[e];
        for (int k = 1; k < w; ++k) {
            if (ts - k >= 0) { const u32x4 v = *(const u32x4*)(xn + off - (size_t)k * D);
                acc[0] += bf_lo(v.x); acc[1] += bf_hi(v.x); acc[2] += bf_lo(v.y); acc[3] += bf_hi(v.y); acc[4] += bf_lo(v.z); acc[5] += bf_hi(v.z); acc[6] += bf_lo(v.w); acc[7] += bf_hi(v.w); }
        }
        const float ic = 1.0f / (float)((ts + 1) < w ? (ts + 1) : w);
        u32x4 o; o.x = pk2(acc[0] * ic - c0[0], acc[1] * ic - c0[1]); o.y = pk2(acc[2] * ic - c0[2], acc[3] * ic - c0[3]);
        o.z = pk2(acc[4] * ic - c0[4], acc[5] * ic - c0[5]); o.w = pk2(acc[6] * ic - c0[6], acc[7] * ic - c0[7]);
        *(u32x4*)(dd + off) = o;
    }
}

__device__ __forceinline__ void fixup_phase(const float* side, const float* cw, const float* cb, bf16_t* Aout, int gtid, int NT) {
    for (int idx = gtid; idx < 128 * 2 * (FF / 4); idx += NT) {
        const int c = 4 * (idx % (FF / 4)), i = (idx / (FF / 4)) & 1, pm = idx / (2 * (FF / 4));
        const int sc = (c >> 7) * 256 + (c & 127);
        const f32x4 z = (f32x4){0.f, 0.f, 0.f, 0.f};
        const bool first = (pm & 15) == 0;
        const float* sp = side + (size_t)pm * 4 * FF2 + sc; const float* pp = sp - 4 * FF2;
        f32x4 o;
        {
            const f32x4 gm2 = first ? z : *(const f32x4*)(pp + 2 * FF2), gm1 = first ? z : *(const f32x4*)(pp + 3 * FF2), g0 = *(const f32x4*)(sp), g1 = *(const f32x4*)(sp + FF2);
            const f32x4 vm2 = first ? z : *(const f32x4*)(pp + 2 * FF2 + 128), vm1 = first ? z : *(const f32x4*)(pp + 3 * FF2 + 128), v0 = *(const f32x4*)(sp + 128), v1 = *(const f32x4*)(sp + FF2 + 128);
            const f32x4 wg0 = *(const f32x4*)(cw + c), wg1 = *(const f32x4*)(cw + FF2 + c), wg2 = *(const f32x4*)(cw + 2 * FF2 + c), bg = *(const f32x4*)(cb + c);
            const f32x4 wv0 = *(const f32x4*)(cw + FF + c), wv1 = *(const f32x4*)(cw + FF2 + FF + c), wv2 = *(const f32x4*)(cw + 2 * FF2 + FF + c), bv = *(const f32x4*)(cb + FF + c);
            const f32x4 cgv = (i == 0) ? (wg2 * g0 + wg1 * gm1 + wg0 * gm2 + bg) : (wg2 * g1 + wg1 * g0 + wg0 * gm1 + bg);
            const f32x4 cvv = (i == 0) ? (wv2 * v0 + wv1 * vm1 + wv0 * vm2 + bv) : (wv2 * v1 + wv1 * v0 + wv0 * vm1 + bv);
#pragma unroll
            for (int e = 0; e < 4; ++e) o[e] = gelu_tanh(cgv[e]) * cvv[e];
        }
        u32x2 w; w.x = pk2(o[0], o[1]); w.y = pk2(o[2], o[3]);
        *(u32x2*)(Aout + (size_t)(pm * 256 + i) * FF + c) = w;
    }
}

__device__ __forceinline__ void attn_phase(const bf16_t* Q, const bf16_t* Kb, const bf16_t* Vt, bf16_t* O, const float* sinks, int blk, int nblk, int wid, int lane) {
    const int q = lane & 31, hi = lane >> 5;
    for (int task = blk * 8 + wid; task < BATCH * 32 * 16 * 4; task += nblk * 8) {
        const int sb = task & 3, gq = (task >> 2) & 3, hk = (task >> 4) & 3, nb = (task >> 6) & 31, b = task >> 11;
        const int hq = hk * 4 + gq;
        const int row0 = b * SEQ + nb * 128 + sb * 32;
        const float sink2 = sinks[hq] * LOG2E;
        bf16x8 qf[4];
        { const bf16_t* qp = Q + (size_t)(row0 + q) * D + hq * 64 + hi * 8;
#pragma unroll
          for (int s = 0; s < 4; ++s) qf[s] = *(const bf16x8*)(qp + s * 16); }
        f32x16 st[5];
#pragma unroll
        for (int kbi = 0; kbi < 5; ++kbi) {
            int ks = nb * 128 - 128 + 32 * (sb + kbi);
            if (ks < 0) ks += 128;
            const bf16_t* kp = Kb + (size_t)(b * SEQ + ks + q) * 256 + hk * 64 + hi * 8;
            f32x16 a = {};
#pragma unroll
            for (int s = 0; s < 4; ++s) { const bf16x8 kf = *(const bf16x8*)(kp + s * 16); a = __builtin_amdgcn_mfma_f32_32x32x16_bf16(kf, qf[s], a, 0, 0, 0); }
            st[kbi] = a;
        }
        const float NEG = -1e30f;
#pragma unroll
        for (int kbi = 0; kbi < 5; ++kbi) {
            const bool dead = (nb == 0) && (sb + kbi < 4);
#pragma unroll
            for (int r = 0; r < 16; ++r) {
                const int kk = (r & 3) + 8 * (r >> 2) + 4 * hi;
                bool ok = !dead;
                if (kbi == 0) ok = ok && (kk > q);
                if (kbi == 4) ok = ok && (kk <= q);
                st[kbi][r] = ok ? st[kbi][r] : NEG;
            }
        }
        float mx = sink2;
#pragma unroll
        for (int kbi = 0; kbi < 5; ++kbi)
#pragma unroll
            for (int r = 0; r < 16; ++r) mx = fmaxf(mx, st[kbi][r]);
        mx = fmaxf(mx, __shfl_xor(mx, 32));
        float sum = 0.f;
        bf16x8 pw[5][2];
#pragma unroll
        for (int kbi = 0; kbi < 5; ++kbi) {
            float p[16];
#pragma unroll
            for (int r = 0; r < 16; ++r) { p[r] = __builtin_amdgcn_exp2f(st[kbi][r] - mx); sum += p[r]; }
#pragma unroll
            for (int h = 0; h < 2; ++h) { u32x4 w; w.x = pk2(p[8 * h + 0], p[8 * h + 1]); w.y = pk2(p[8 * h + 2], p[8 * h + 3]); w.z = pk2(p[8 * h + 4], p[8 * h + 5]); w.w = pk2(p[8 * h + 6], p[8 * h + 7]);
                pw[kbi][h] = __builtin_bit_cast(bf16x8, w); }
        }
        sum += __shfl_xor(sum, 32);
        const float inv = 1.0f / (sum + __builtin_amdgcn_exp2f(sink2 - mx));
        f32x16 ot[2]; ot[0] = f32x16{}; ot[1] = f32x16{};
#pragma unroll
        for (int kbi = 0; kbi < 5; ++kbi) {
            int ks = nb * 128 - 128 + 32 * (sb + kbi);
            if (ks < 0) ks += 128;
#pragma unroll
            for (int h = 0; h < 2; ++h)
#pragma unroll
                for (int dh = 0; dh < 2; ++dh) {
                    const bf16x8 vf = *(const bf16x8*)(Vt + ((size_t)((b * NKVH + hk) * HD + dh * 32 + q)) * SEQ + ks + h * 16 + hi * 8);
                    ot[dh] = __builtin_amdgcn_mfma_f32_32x32x16_bf16(vf, pw[kbi][h], ot[dh], 0, 0, 0);
                }
        }
        bf16_t* op = O + (size_t)(row0 + q) * D + hq * 64 + 4 * hi;
#pragma unroll
        for (int dh = 0; dh < 2; ++dh)
#pragma unroll
            for (int rg = 0; rg < 4; ++rg) { u32x2 w; w.x = pk2(ot[dh][4 * rg + 0] * inv, ot[dh][4 * rg + 1] * inv); w.y = pk2(ot[dh][4 * rg + 2] * inv, ot[dh][4 * rg + 3] * inv);
                *(u32x2*)(op + dh * 32 + 8 * rg) = w; }
    }
}

enum { T_PRO = 0, T_ROWA, T_DIFF, T_POOLG, T_ROWB, T_QKV, T_ATTN, T_WO, T_GLU, T_FIX, T_DOWN };
constexpr int NPH = 31;
#ifndef PH_MASK
#define PH_MASK 0xFFFF
#endif
#define PH_ON(t) (((PH_MASK) >> (t)) & 1)
__host__ __device__ __forceinline__ void decode_phase(int ph, int& type, int& layer) {
    if (ph == 0) { type = T_PRO; layer = 0; return; }
    if (ph <= 6) { type = (int)((0xA98432ull >> (4 * (ph - 1))) & 15); layer = 0; return; }
    if (ph <= 13) { type = (int)((0xA984321ull >> (4 * (ph - 7))) & 15); layer = 1; return; }
    if (ph <= 29) { type = (int)((0xA9847651ull >> (4 * ((ph - 14) & 7))) & 15); layer = 2 + ((ph - 14) >> 3); return; }
    type = T_ROWA; layer = 4;
}

template <bool COOP>
__global__ void __launch_bounds__(NWAVES * 64, 2) yoco_fwd(Args a) {
    extern __shared__ __attribute__((aligned(16))) unsigned char lds_raw[];
    LAS unsigned char* lds = (LAS unsigned char*)lds_raw;
    const int G = gridDim.x, blk = blockIdx.x;
    const int wave_s = __builtin_amdgcn_readfirstlane(threadIdx.x >> 6);
    int ph0 = a.ph_lo;
    if (PH_ON(T_PRO) && ph0 == 0) {
        int lane = __builtin_amdgcn_mbcnt_hi(~0u, __builtin_amdgcn_mbcnt_lo(~0u, 0u)); asm volatile("" : "+v"(lane));
        const int wave = wave_s, tid = wave * 64 + lane;
        const int gw = blk * NWAVES + wave, NGW = G * NWAVES;
        unsigned char* ws = a.ws; asm volatile("" : "+s"(ws));
        bf16_t* BT1 = (bf16_t*)(ws + WS_BT1); bf16_t* BT2 = (bf16_t*)(ws + WS_BT2); bf16_t* BTQKV = (bf16_t*)(ws + WS_BTQKV); bf16_t* BTO = (bf16_t*)(ws + WS_BTO); bf16_t* BTP = (bf16_t*)(ws + WS_BTP);
        float* COSB = (float*)(ws + WS_COS); float* SINB = (float*)(ws + WS_SIN); bf16_t* XN = (bf16_t*)(ws + WS_XN);
        {
            LAS float* scr = (LAS float*)(lds + wave * 16384);
            constexpr int I_IN = 16 * 176, I_OUT = 44 * 32, I_Q = 16 * 32, I_KV = 16 * 16, I_O = 16 * 32, I_P = 4 * 8;
            constexpr int NITEMS = 4 * I_IN + 4 * I_OUT + 2 * I_Q + I_KV + 2 * I_O + 8 * I_P;
            for (int it = gw; it < NITEMS; it += NGW) {
                int r = it;
                if (r < 4 * I_IN) { const int l = r / I_IN; r %= I_IN; const int kb = r / 176, nbk = r % 176, n0 = nbk * 32;
                    const int bj = n0 / FF, rem = n0 % FF, pn = rem / 128, j = rem % 128;
                    transpose_item(a.ffn_w_in + (size_t)l * D * FF2, FF2, kb * 64, n0, BT1 + (size_t)l * FF2 * D, D, pn * 256 + bj * 128 + j, a.ffn_pre_g + l * D, nullptr, 1.0f, scr, lane); continue; }
                r -= 4 * I_IN;
                if (r < 4 * I_OUT) { const int l = r / I_OUT; r %= I_OUT; const int kb = r / 32, nbk = r % 32;
                    transpose_item(a.ffn_w_out + (size_t)l * FF * D, D, kb * 64, nbk * 32, BT2 + (size_t)l * D * FF, FF, nbk * 32, nullptr, nullptr, 1.0f, scr, lane); continue; }
                r -= 4 * I_OUT;
                if (r < 2 * I_Q) { const int j2 = r / I_Q; r %= I_Q; const int kb = r / 32, nbk = r % 32, n0 = nbk * 32;
                    const int head = n0 >> 6, half = (n0 >> 5) & 1;
                    transpose_item(a.w_q + (size_t)j2 * D * D, D, kb * 64, n0, BTQKV + (size_t)j2 * NQKV * D, D, (head >> 2) * 256 + half * 128 + (head & 3) * 32, a.mix_pre_g + (2 + j2) * D, nullptr, 0.125f * LOG2E, scr, lane); continue; }
                r -= 2 * I_Q;
                if (r < I_KV) { const int kb = r / 16, nbk = r % 16, n0 = nbk * 32;
                    int orow; if (n0 < 256) { const int head = n0 >> 6, half = (n0 >> 5) & 1; orow = 1024 + half * 128 + head * 32; } else orow = 1280 + (n0 - 256);
                    transpose_item(a.w_kv, 512, kb * 64, n0, BTQKV, D, orow, a.kv_norm_g, nullptr, 1.0f, scr, lane); continue; }
                r -= I_KV;
                if (r < 2 * I_O) { const int j2 = r / I_O; r %= I_O; const int kb = r / 32, nbk = r % 32;
                    transpose_item(a.w_o + (size_t)j2 * D * D, D, kb * 64, nbk * 32, BTO + (size_t)j2 * D * D, D, nbk * 32, nullptr, nullptr, 1.0f, scr, lane); continue; }
                r -= 2 * I_O;
                { const int lg = r / I_P; r %= I_P; const int l = lg >> 2, grp = lg & 3, kb = r / 8, nbk = r % 8;
                    transpose_item(a.pool_w + (size_t)lg * 256 * 256, 256, kb * 64, nbk * 32, BTP + (size_t)l * D * 256, 256, grp * 256 + nbk * 32, a.mix_pre_g + l * D + grp * 256, a.pool_scale + l * D + grp * 256, 1.0f, scr, lane); }
            }
            for (int idx = blk * (NWAVES * 64) + tid; idx < M * 32; idx += G * NWAVES * 64) {
                const int row = idx >> 5, i = idx & 31;
                const float ang = (float)a.positions[row] * a.inv_freq[i];
                const double ad = (double)ang; const double kq = rint(ad * 0.63661977236758134308); const double rr = ad - kq * 1.57079632679489661923;
                const double r2 = rr * rr;
                const double sv = rr * (1.0 + r2 * (-1.0 / 6 + r2 * (1.0 / 120 + r2 * (-1.0 / 5040 + r2 * (1.0 / 362880 + r2 * (-1.0 / 39916800 + r2 * (1.0 / 6227020800.0)))))));
                const double cv = 1.0 + r2 * (-0.5 + r2 * (1.0 / 24 + r2 * (-1.0 / 720 + r2 * (1.0 / 40320 + r2 * (-1.0 / 3628800 + r2 * (1.0 / 479001600.0 + r2 * (-1.0 / 87178291200.0)))))));
                const int qd = ((int)kq) & 3;
                const double c = (qd == 0) ? cv : (qd == 1) ? -sv : (qd == 2) ? -cv : sv;
                const double s = (qd == 0) ? sv : (qd == 1) ? cv : (qd == 2) ? -sv : -cv;
                COSB[idx] = (float)c; SINB[idx] = (float)s;
            }
            row_phase(a.x, nullptr, nullptr, nullptr, XN, gw, NGW, lane);
        }
        ph0 = 1;
        if (ph0 < a.ph_hi) { if constexpr (COOP) { cg::this_grid().sync(); } }
    }
    for (int ph = ph0 < 1 ? 1 : ph0; ph < a.ph_hi; ++ph) {
        int type, layer; decode_phase(ph, type, layer);
        int lane = __builtin_amdgcn_mbcnt_hi(~0u, __builtin_amdgcn_mbcnt_lo(~0u, 0u)); asm volatile("" : "+v"(lane));
        const int wave = wave_s, tid = wave * 64 + lane;
        const int gw = blk * NWAVES + wave, NGW = G * NWAVES;
        unsigned char* ws = a.ws; asm volatile("" : "+s"(ws));
        bf16_t* BT1 = (bf16_t*)(ws + WS_BT1); bf16_t* BT2 = (bf16_t*)(ws + WS_BT2); bf16_t* BTQKV = (bf16_t*)(ws + WS_BTQKV); bf16_t* BTO = (bf16_t*)(ws + WS_BTO); bf16_t* BTP = (bf16_t*)(ws + WS_BTP);
        float* COSB = (float*)(ws + WS_COS); float* SINB = (float*)(ws + WS_SIN); float* SIDE = (float*)(ws + WS_SIDE);
        bf16_t* XN = (bf16_t*)(ws + WS_XN); bf16_t* TB = (bf16_t*)(ws + WS_T); bf16_t* KB = (bf16_t*)(ws + WS_K); bf16_t* VT = (bf16_t*)(ws + WS_VT);
        bf16_t* AB = (bf16_t*)(ws + WS_A); bf16_t* DB = AB; bf16_t* QO = AB;
        if (false) {
        } else if (PH_ON(T_ROWA) && type == T_ROWA) {
            row_phase(a.out, TB, a.ffn_post_g + (layer - 1) * D, a.out, layer < DEPTH ? XN : nullptr, gw, NGW, lane);
        } else if (PH_ON(T_ROWB) && type == T_ROWB) {
            row_phase(layer == 0 ? a.x : a.out, TB, a.mix_post_g + layer * D, a.out, XN, gw, NGW, lane);
        } else if (PH_ON(T_DIFF) && type == T_DIFF) {
            diff_phase(XN, DB, gw, NGW, lane);
        } else if (PH_ON(T_FIX) && type == T_FIX) {
            fixup_phase(SIDE, a.ffn_conv_w + (size_t)layer * 3 * FF2, a.ffn_conv_b + (size_t)layer * FF2, AB, blk * (NWAVES * 64) + tid, G * NWAVES * 64);
        } else if (PH_ON(T_ATTN) && type == T_ATTN) {
            attn_phase(QO, KB, VT, QO, a.sinks + (layer - 2) * NQH, blk, G, wave, lane);
        } else if (PH_ON(T_GLU) && type == T_GLU) {
            pg8::Gemm g{XN, BT1 + (size_t)layer * FF2 * D, D, D, D, 0}; pg8::StaticOrder S; S.init(M, FF2, G, blk);
            pg8::EpiGlu E{AB, a.ffn_conv_w + (size_t)layer * 3 * FF2, a.ffn_conv_b + (size_t)layer * FF2, SIDE};
            pg8::gemm_phase<pg8::EpiGlu, pg8::StaticOrder, true, true>(lds, g, S, E, tid);
        } else if (PH_ON(T_QKV) && type == T_QKV) {
            pg8::Gemm g{XN, BTQKV + (size_t)(layer - 2) * NQKV * D, D, D, D, 0}; pg8::StaticOrder S; S.init(M, layer == 2 ? NQKV : D, G, blk);
            pg8::EpiQKV E{QO, KB, VT, COSB, SINB};
            pg8::gemm_phase<pg8::EpiQKV, pg8::StaticOrder, true, true>(lds, g, S, E, tid);
        } else if (PH_ON(T_DOWN)) {
            pg8::Gemm g;
            if (type == T_POOLG) g = pg8::Gemm{DB, BTP + (size_t)layer * D * 256, D, 256, 256, 256};
            else if (type == T_WO) g = pg8::Gemm{QO, BTO + (size_t)(layer - 2) * D * D, D, D, D, 0};
            else g = pg8::Gemm{AB, BT2 + (size_t)layer * D * FF, FF, FF, FF, 0};
            pg8::StaticOrder S; S.init(M, D, G, blk);
            pg8::EpiBf16 E{TB, D};
            pg8::gemm_phase<pg8::EpiBf16, pg8::StaticOrder, true, true>(lds, g, S, E, tid);
        }
        if (ph + 1 < a.ph_hi) {
            if constexpr (COOP) { cg::this_grid().sync(); }
        }
    }
}

extern "C" void kernel_launch(void* const* d_in, const int* in_sizes, int n_in, void* d_out, int out_size, void* d_ws, size_t ws_size, hipStream_t stream) {
    static int grid = 0;
    static float invf[32];
    if (grid == 0) {
        if (n_in != 17 || out_size != M * D || ws_size < WS_END) { fprintf(stderr, "kernel_launch: unexpected shapes (n_in %d, out %d, ws %zu)\n", n_in, out_size, ws_size); grid = -1; return; }
        int dev = 0, cus = 0, per_cu = 0;
        (void)hipGetDevice(&dev); (void)hipDeviceGetAttribute(&cus, hipDeviceAttributeMultiprocessorCount, dev);
#if defined(MK_PER_PHASE)
        const void* kfn = (const void*)yoco_fwd<false>;
#else
        const void* kfn = (const void*)yoco_fwd<true>;
#endif
        (void)hipFuncSetAttribute(kfn, hipFuncAttributeMaxDynamicSharedMemorySize, LDS_BYTES);
        (void)hipOccupancyMaxActiveBlocksPerMultiprocessor(&per_cu, kfn, NWAVES * 64, LDS_BYTES);
        if (per_cu < 1) { fprintf(stderr, "kernel_launch: occupancy query says %d blocks per CU\n", per_cu); per_cu = 1; }
        (void)hipGetLastError();
        grid = cus * per_cu;
        for (int i = 0; i < 32; ++i) invf[i] = 1.0f / powf(10000.0f, (float)(2 * i) / 64.0f);
    }
    if (grid < 0) return;
    Args a{};
    a.x = (const float*)d_in[0]; a.positions = (const int*)d_in[1]; a.mix_pre_g = (const float*)d_in[2]; a.mix_post_g = (const float*)d_in[3]; a.pool_w = (const float*)d_in[4];
    a.pool_scale = (const float*)d_in[5]; a.kv_norm_g = (const float*)d_in[6]; a.w_kv = (const float*)d_in[7]; a.w_q = (const float*)d_in[8]; a.w_o = (const float*)d_in[9];
    a.sinks = (const float*)d_in[10]; a.ffn_pre_g = (const float*)d_in[11]; a.ffn_post_g = (const float*)d_in[12]; a.ffn_w_in = (const float*)d_in[13]; a.ffn_conv_w = (const float*)d_in[14];
    a.ffn_conv_b = (const float*)d_in[15]; a.ffn_w_out = (const float*)d_in[16];
    a.out = (float*)d_out; a.ws = (unsigned char*)d_ws;
    for (int i = 0; i < 32; ++i) a.inv_freq[i] = invf[i];
#if defined(MK_PER_PHASE)
    for (int ph = 0; ph < NPH; ++ph) { a.ph_lo = ph; a.ph_hi = ph + 1; hipLaunchKernelGGL(yoco_fwd<false>, dim3(grid), dim3(NWAVES * 64), LDS_BYTES, stream, a); }
#else
    a.ph_lo = 0; a.ph_hi = NPH;
    void* args[] = {&a};
    hipError_t e = hipLaunchCooperativeKernel((const void*)yoco_fwd<true>, dim3(grid), dim3(NWAVES * 64), args, LDS_BYTES, stream);
    if (e != hipSuccess) fprintf(stderr, "cooperative launch failed: %s (grid %d)\n", hipGetErrorString(e), grid);
#endif
}
```

```cpp
#include <hip/hip_runtime.h>
#include <hip/hip_cooperative_groups.h>
#include <cstdio>
#include <cstdint>
#include <cmath>
namespace cg = cooperative_groups;

#define LAS __attribute__((address_space(3)))
#define PG8_LAS LAS
typedef unsigned short bf16_t;
typedef short bf16x8 __attribute__((ext_vector_type(8)));
typedef float f32x4 __attribute__((ext_vector_type(4)));
typedef float f32x16 __attribute__((ext_vector_type(16)));
typedef unsigned u32x4 __attribute__((ext_vector_type(4)));
typedef unsigned u32x2 __attribute__((ext_vector_type(2)));
typedef float f32x2_t __attribute__((ext_vector_type(2)));
typedef __bf16 bf16x2_t __attribute__((ext_vector_type(2)));

constexpr int D = 1024, BATCH = 8, SEQ = 4096, M = BATCH * SEQ, DEPTH = 4, NA = 2, FF = 2816, FF2 = 5632;
constexpr int HD = 64, NQH = 16, NKVH = 4, NQKV = 1536;
constexpr float RMS_EPS = 1e-6f;
constexpr float LOG2E = 1.4426950408889634f;

__device__ __forceinline__ unsigned pk2(float lo, float hi) { f32x2_t v = {lo, hi}; bf16x2_t b = __builtin_convertvector(v, bf16x2_t); return __builtin_bit_cast(unsigned, b); }
__device__ __forceinline__ float bf_lo(unsigned u) { return __builtin_bit_cast(float, u << 16); }
__device__ __forceinline__ float bf_hi(unsigned u) { return __builtin_bit_cast(float, u & 0xffff0000u); }
template <int CTRL> __device__ __forceinline__ float dppf(float old, float src) {
    return __builtin_bit_cast(float, __builtin_amdgcn_update_dpp(__builtin_bit_cast(int, old), __builtin_bit_cast(int, src), CTRL, 0xf, 0xf, false));
}
constexpr int DPP_SHR1 = 0x111, DPP_SHR2 = 0x112, DPP_ROR1 = 0x121, DPP_ROR2 = 0x122;
__device__ __forceinline__ float gelu_tanh(float x) {
    const float c1 = -2.0f * 0.7978845608028654f * LOG2E, c2 = c1 * 0.044715f;
    const float t = x * (c1 + c2 * x * x);
    const float e = __builtin_amdgcn_exp2f(t);
    return x * __builtin_amdgcn_rcpf(1.0f + e);
}

namespace pg8 {
constexpr int BM = 256, BK = 64, HALF = 128, HTB = HALF * BK * 2  , STAGE_BYTES = 8 * HTB, NXCD = 8, WGM = 8;
__host__ __device__ __forceinline__ int lds_byte(int r, int c) { const int st = (r >> 4) * 2 + (c >> 5), rr = r & 15, cc = c & 31, ob = rr * 64 + cc * 2; return st * 1024 + (ob ^ (((ob >> 9) & 1) << 5)); }
__host__ __device__ __forceinline__ void stage_rc(int b, int& R, int& C) { const int st = b / 1024, sb = b % 1024, swz = sb ^ (((sb >> 9) & 1) << 5); R = (st >> 1) * 16 + swz / 64; C = (st & 1) * 32 + (swz % 64) / 2; }
__host__ __device__ __forceinline__ int perm32(int rho) { const int n = rho >> 4, i = rho & 15; return 8 * (i >> 2) + 4 * n + (i & 3); }

struct Unit { int pm, pn; };
struct Gemm { const bf16_t* A; const bf16_t* Bt; int lda, ldb, K, acol; };

struct StaticOrder {
    int nM, nN, nwg, G, c;
    __host__ __device__ void init(int M_, int N_, int G_, int c_) { nM = M_ / BM; nN = N_ / BM; nwg = nM * nN; G = G_; c = c_; }
    __host__ __device__ bool next(int i, Unit& u) const {
        const long L = (long)i * G + c; if (L >= nwg) return false;
        int wgid = (int)L; { const int q = nwg / NXCD, r = nwg % NXCD, xcd = wgid % NXCD, off = wgid / NXCD; wgid = (xcd < r ? xcd * (q + 1) : r * (q + 1) + (xcd - r) * q) + off; }
        const int nig = WGM * nN, gid = wgid / nig, fm = gid * WGM, gsz = (nM - fm) < WGM ? (nM - fm) : WGM;
        u.pm = fm + ((wgid % nig) % gsz); u.pn = (wgid % nig) / gsz; return true;
    }
    __device__ __forceinline__ void a_ready(const Unit&) const {}
    __device__ __forceinline__ void done(const Unit&) const {}
};

struct EpiBf16 {
    static constexpr bool PERM = true, AFTER_DRAIN = false;
    bf16_t* O; int ldc;
    __device__ __forceinline__ void operator()(f32x4 (&acc)[2][2][4][2], const Unit& u, int wr, int wc, int fr, int fq, LAS unsigned char*) const {
        const int row0 = u.pm * BM + wr * 64 + fr, col0 = u.pn * BM + wc * 32 + 8 * fq;
#pragma unroll
        for (int ai = 0; ai < 2; ++ai)
#pragma unroll
            for (int m = 0; m < 4; ++m) { bf16_t* rowp = O + (size_t)(row0 + ai * HALF + m * 16) * ldc + col0;
#pragma unroll
                for (int bj = 0; bj < 2; ++bj) { const f32x4 v0 = acc[ai][bj][m][0], v1 = acc[ai][bj][m][1];
                    u32x4 w; w.x = pk2(v0[0], v0[1]); w.y = pk2(v0[2], v0[3]); w.z = pk2(v1[0], v1[1]); w.w = pk2(v1[2], v1[3]);
                    *(u32x4*)(rowp + bj * HALF) = w; } }
    }
};

struct EpiQKV {
    static constexpr bool PERM = true, AFTER_DRAIN = false;
    bf16_t* Q; bf16_t* Kb; bf16_t* Vt; const float* cs; const float* sn;
    __device__ __forceinline__ void operator()(f32x4 (&acc)[2][2][4][2], const Unit& u, int wr, int wc, int fr, int fq, LAS unsigned char*) const {
        if (u.pn <= 4) {
            bf16_t* base; int ld, head;
            if (u.pn < 4) { base = Q; ld = D; head = u.pn * 4 + wc; } else { base = Kb; ld = 256; head = wc; }
#pragma unroll
            for (int ai = 0; ai < 2; ++ai)
#pragma unroll
                for (int m = 0; m < 4; ++m) {
                    const int row = u.pm * BM + ai * HALF + wr * 64 + m * 16 + fr;
                    const float* cp = cs + (size_t)row * 32 + 8 * fq; const float* sp = sn + (size_t)row * 32 + 8 * fq;
                    u32x4 w1, w2;
#pragma unroll
                    for (int n = 0; n < 2; ++n) {
                        const f32x4 c = *(const f32x4*)(cp + 4 * n), s = *(const f32x4*)(sp + 4 * n);
                        const f32x4 x1 = acc[ai][0][m][n], x2 = acc[ai][1][m][n];
                        const f32x4 o1 = x1 * c - x2 * s, o2 = x2 * c + x1 * s;
                        if (n == 0) { w1.x = pk2(o1[0], o1[1]); w1.y = pk2(o1[2], o1[3]); w2.x = pk2(o2[0], o2[1]); w2.y = pk2(o2[2], o2[3]); }
                        else        { w1.z = pk2(o1[0], o1[1]); w1.w = pk2(o1[2], o1[3]); w2.z = pk2(o2[0], o2[1]); w2.w = pk2(o2[2], o2[3]); }
                    }
                    bf16_t* op = base + (size_t)row * ld + head * 64 + 8 * fq;
                    *(u32x4*)op = w1; *(u32x4*)(op + 32) = w2;
                }
        } else {
            const int pos = (fr & 3) + 4 * ((fr >> 3) & 1) + 8 * ((fr >> 2) & 1);
#pragma unroll
            for (int ai = 0; ai < 2; ++ai)
#pragma unroll
                for (int m = 0; m < 4; ++m) {
                    const int row = u.pm * BM + ai * HALF + wr * 64 + m * 16;
                    const int b = row >> 12, s = (row & 4095) + pos;
#pragma unroll
                    for (int bj = 0; bj < 2; ++bj)
#pragma unroll
                        for (int n = 0; n < 2; ++n)
#pragma unroll
                            for (int e = 0; e < 4; ++e) {
                                const int c = bj * HALF + wc * 32 + 8 * fq + 4 * n + e, hk = c >> 6, d = c & 63;
                                Vt[((size_t)((b * NKVH + hk) * HD + d)) * SEQ + s] = (bf16_t)(pk2(acc[ai][bj][m][n][e], 0.f) & 0xffffu);
                            }
                }
        }
    }
};

struct EpiGlu {
    static constexpr bool PERM = true, AFTER_DRAIN = false;
    bf16_t* Aout; const float* cw; const float* cb; float* side;
    __device__ __forceinline__ void operator()(f32x4 (&acc)[2][2][4][2], const Unit& u, int wr, int wc, int fr, int fq, LAS unsigned char* xl) const {
        LAS f32x4* X = (LAS f32x4*)xl;
        const int tc0 = wc * 32 + 8 * fq;
        if (fr >= 14) {
#pragma unroll
            for (int ai = 0; ai < 2; ++ai)
#pragma unroll
                for (int bj = 0; bj < 2; ++bj)
#pragma unroll
                    for (int n = 0; n < 2; ++n) X[((ai * 2 + wr) * 2 + (fr - 14)) * 64 + ((bj * HALF + tc0 + 4 * n) >> 2)] = acc[ai][bj][3][n];
        }
        if (wr == 0 && fr < 2) {
#pragma unroll
            for (int bj = 0; bj < 2; ++bj)
#pragma unroll
                for (int n = 0; n < 2; ++n) *(f32x4*)(side + ((size_t)(u.pm * 4 + fr)) * FF2 + u.pn * 256 + bj * HALF + tc0 + 4 * n) = acc[0][bj][0][n];
        }
        if (wr == 1 && fr >= 14) {
#pragma unroll
            for (int bj = 0; bj < 2; ++bj)
#pragma unroll
                for (int n = 0; n < 2; ++n) *(f32x4*)(side + ((size_t)(u.pm * 4 + 2 + (fr - 14))) * FF2 + u.pn * 256 + bj * HALF + tc0 + 4 * n) = acc[1][bj][3][n];
        }
        asm volatile("s_waitcnt lgkmcnt(0)" ::: "memory"); __builtin_amdgcn_s_barrier(); asm volatile("" ::: "memory");
        const int row0 = u.pm * BM + wr * 64 + fr;
#pragma unroll
        for (int n = 0; n < 2; ++n) {
            const int c0 = u.pn * 128 + tc0 + 4 * n;
            const f32x4 wg0 = *(const f32x4*)(cw + c0), wg1 = *(const f32x4*)(cw + FF2 + c0), wg2 = *(const f32x4*)(cw + 2 * FF2 + c0), bg = *(const f32x4*)(cb + c0);
            const f32x4 wv0 = *(const f32x4*)(cw + FF + c0), wv1 = *(const f32x4*)(cw + FF2 + FF + c0), wv2 = *(const f32x4*)(cw + 2 * FF2 + FF + c0), bv = *(const f32x4*)(cb + FF + c0);
#pragma unroll
            for (int ai = 0; ai < 2; ++ai) {
                const int sidx = ai * 2 + wr;
                f32x4 hg = (f32x4){0.f, 0.f, 0.f, 0.f}, hv = hg;
                if (sidx > 0) { hg = X[((sidx - 1) * 2 + (fr & 1)) * 64 + ((tc0 + 4 * n) >> 2)]; hv = X[((sidx - 1) * 2 + (fr & 1)) * 64 + ((HALF + tc0 + 4 * n) >> 2)]; }
                f32x4 p1g, p2g, p1v, p2v;
#pragma unroll
                for (int e = 0; e < 4; ++e) { p1g[e] = dppf<DPP_ROR1>(hg[e], hg[e]); p2g[e] = dppf<DPP_ROR2>(hg[e], hg[e]); p1v[e] = dppf<DPP_ROR1>(hv[e], hv[e]); p2v[e] = dppf<DPP_ROR2>(hv[e], hv[e]); }
#pragma unroll
                for (int m = 0; m < 4; ++m) {
                    const f32x4 g = acc[ai][0][m][n], v = acc[ai][1][m][n];
                    f32x4 o;
#pragma unroll
                    for (int e = 0; e < 4; ++e) {
                        const float g1 = dppf<DPP_SHR1>(p1g[e], g[e]), g2 = dppf<DPP_SHR2>(p2g[e], g[e]);
                        const float v1 = dppf<DPP_SHR1>(p1v[e], v[e]), v2 = dppf<DPP_SHR2>(p2v[e], v[e]);
                        p1g[e] = dppf<DPP_ROR1>(g[e], g[e]); p2g[e] = dppf<DPP_ROR2>(g[e], g[e]);
                        p1v[e] = dppf<DPP_ROR1>(v[e], v[e]); p2v[e] = dppf<DPP_ROR2>(v[e], v[e]);
                        const float cgv = wg2[e] * g[e] + wg1[e] * g1 + wg0[e] * g2 + bg[e];
                        const float cvv = wv2[e] * v[e] + wv1[e] * v1 + wv0[e] * v2 + bv[e];
                        o[e] = gelu_tanh(cgv) * cvv;
                    }
                    u32x2 w; w.x = pk2(o[0], o[1]); w.y = pk2(o[2], o[3]);
                    *(u32x2*)(Aout + (size_t)(row0 + ai * HALF + m * 16) * FF + u.pn * 128 + tc0 + 4 * n) = w;
                }
                __builtin_amdgcn_sched_barrier(0);
            }
        }
    }
};

template <class Epi, class Sched, bool ALIGN_EPI = false, bool SP2 = false>
__device__ __forceinline__ void gemm_phase(PG8_LAS unsigned char* lds, const Gemm g, const Sched& S, const Epi& E, const int tid) {
    const int wid = __builtin_amdgcn_readfirstlane(tid >> 6), lane = tid & 63, wr = wid >> 2, wc = wid & 3, fr = lane & 15, fq = lane >> 4;
    const int K = g.K, nt = K / BK;
    unsigned voffA[2], voffB[2];
#pragma unroll
    for (int i = 0; i < 2; ++i) { int R, C; stage_rc(tid * 16 + i * 8192, R, C); const int Rb = Epi::PERM ? ((R & ~31) + perm32(R & 31)) : R;
        voffA[i] = (unsigned)(R * g.lda + C) * 2u; voffB[i] = (unsigned)(Rb * g.ldb + C) * 2u; }
    const size_t kstep = (size_t)(BK * 2);
    const size_t hstepA = (size_t)HALF * g.lda * 2, hstepB = (size_t)HALF * g.ldb * 2;
    const size_t tstepA = 2 * hstepA, tstepB = 2 * hstepB;
    const unsigned ldsw = (unsigned)wid * 1024u;
    const int aoff = lds_byte(wr * 64 + fr, fq * 8), boff = lds_byte(wc * 32 + fr, fq * 8);
#define PG8_SA(b, h) (((b) * 2 + (h)) * HTB)
#define PG8_SB(b, h) ((4 + (b) * 2 + (h)) * HTB)
#define PG8_STAGE(bufoff, gbase, voff) do { _Pragma("unroll") for (int _i = 0; _i < 2; ++_i) \
        __builtin_amdgcn_global_load_lds((const unsigned*)((const char*)(gbase) + (voff)[_i]), (PG8_LAS unsigned*)(lds + (bufoff) + ldsw + _i * 8192), 16, 0, 0); } while (0)
#define PG8_LDA(dst, b, h) do { _Pragma("unroll") for (int m = 0; m < 4; ++m) _Pragma("unroll") for (int k = 0; k < 2; ++k) dst[m][k] = *(const PG8_LAS bf16x8*)(lds + PG8_SA(b, h) + aoff + m * 2048 + k * 1024); } while (0)
#define PG8_LDB(dst, b, h) do { _Pragma("unroll") for (int n = 0; n < 2; ++n) _Pragma("unroll") for (int k = 0; k < 2; ++k) dst[n][k] = *(const PG8_LAS bf16x8*)(lds + PG8_SB(b, h) + boff + n * 2048 + k * 1024); } while (0)
#define PG8_MMA(ai, bj, At, Bt) do { __builtin_amdgcn_s_setprio(1); _Pragma("unroll") for (int m = 0; m < 4; ++m) _Pragma("unroll") for (int n = 0; n < 2; ++n) _Pragma("unroll") for (int k = 0; k < 2; ++k) \
        acc[ai][bj][m][n] = __builtin_amdgcn_mfma_f32_16x16x32_bf16(Bt[n][k], At[m][k], acc[ai][bj][m][n], 0, 0, 0); __builtin_amdgcn_s_setprio(0); } while (0)
#define PG8_WAIT_V(n) asm volatile("s_waitcnt vmcnt(" #n ")" ::: "memory")
#define PG8_WAIT_L(n) asm volatile("s_waitcnt lgkmcnt(" #n ")" ::: "memory")
#define PG8_BAR __builtin_amdgcn_s_barrier()
#define PG8_SCHED __builtin_amdgcn_sched_barrier(0)
    Unit cur, nxt; int ui = 0;
    if (!S.next(0, cur)) return;
    f32x4 acc[2][2][4][2];
#pragma unroll
    for (int a = 0; a < 2; ++a)
#pragma unroll
        for (int b = 0; b < 2; ++b)
#pragma unroll
            for (int m = 0; m < 4; ++m)
#pragma unroll
                for (int n = 0; n < 2; ++n) acc[a][b][m][n] = (f32x4){0.f, 0.f, 0.f, 0.f};
    bf16x8 At[4][2], B0[2][2], B1[2][2];
    const char* cA = (const char*)g.A + (size_t)cur.pm * tstepA + (size_t)cur.pn * g.acol * 2; const char* cB = (const char*)g.Bt + (size_t)cur.pn * tstepB;
    S.a_ready(cur);
    if constexpr (SP2) {
        PG8_STAGE(PG8_SB(0, 0), cB, voffB); PG8_STAGE(PG8_SB(0, 1), cB + hstepB, voffB); PG8_STAGE(PG8_SA(0, 0), cA, voffA); PG8_STAGE(PG8_SA(0, 1), cA + hstepA, voffA);
        if (wr == 1) PG8_BAR;
        PG8_WAIT_V(2); PG8_BAR;
        PG8_STAGE(PG8_SB(1, 0), cB + kstep, voffB); PG8_STAGE(PG8_SA(1, 0), cA + kstep, voffA); PG8_STAGE(PG8_SB(1, 1), cB + hstepB + kstep, voffB);
        PG8_WAIT_V(6); PG8_BAR;
    } else {
        PG8_STAGE(PG8_SB(0, 0), cB, voffB); PG8_STAGE(PG8_SA(0, 0), cA, voffA); PG8_STAGE(PG8_SB(0, 1), cB + hstepB, voffB); PG8_STAGE(PG8_SA(0, 1), cA + hstepA, voffA);
        if (wr == 1) PG8_BAR;
        PG8_WAIT_V(4); PG8_BAR;
        PG8_STAGE(PG8_SB(1, 0), cB + kstep, voffB); PG8_STAGE(PG8_SA(1, 0), cA + kstep, voffA); PG8_STAGE(PG8_SB(1, 1), cB + hstepB + kstep, voffB);
        PG8_WAIT_V(6); PG8_BAR;
    }
    for (;;) {
        const bool has_next = S.next(ui + 1, nxt);
        const char* nA = has_next ? (const char*)g.A + (size_t)nxt.pm * tstepA + (size_t)nxt.pn * g.acol * 2 : cA; const char* nB = has_next ? (const char*)g.Bt + (size_t)nxt.pn * tstepB : cB;
        for (int t = 0; t < nt; t += 2) {
            const bool last = (t == nt - 2);
            const char* a1 = cA + (size_t)(t + 1) * kstep;
            const char* a2 = last ? nA : cA + (size_t)(t + 2) * kstep; const char* b2 = last ? nB : cB + (size_t)(t + 2) * kstep;
            const char* a3 = a2 + kstep; const char* b3 = b2 + kstep;
            if (last && has_next) S.a_ready(nxt);
            if constexpr (SP2) {
            PG8_LDB(B0, 0, 0); PG8_LDB(B1, 0, 1); PG8_SCHED; PG8_LDA(At, 0, 0); PG8_STAGE(PG8_SA(1, 1), a1 + hstepA, voffA);
            PG8_WAIT_V(8); PG8_WAIT_L(0); PG8_BAR; PG8_MMA(0, 0, At, B0); PG8_MMA(0, 1, At, B1); PG8_BAR; PG8_SCHED;
            PG8_LDA(At, 0, 1); PG8_STAGE(PG8_SB(0, 0), b2, voffB); PG8_STAGE(PG8_SB(0, 1), b2 + hstepB, voffB); PG8_STAGE(PG8_SA(0, 0), a2, voffA);
            PG8_WAIT_V(8); PG8_WAIT_L(0); PG8_BAR; PG8_MMA(1, 0, At, B0); PG8_MMA(1, 1, At, B1); PG8_BAR; PG8_SCHED;
            PG8_LDB(B0, 1, 0); PG8_LDB(B1, 1, 1); PG8_SCHED; PG8_LDA(At, 1, 0); PG8_STAGE(PG8_SA(0, 1), a2 + hstepA, voffA);
            PG8_WAIT_V(8); PG8_WAIT_L(0); PG8_BAR; PG8_MMA(0, 0, At, B0); PG8_MMA(0, 1, At, B1); PG8_BAR; PG8_SCHED;
            PG8_LDA(At, 1, 1); PG8_STAGE(PG8_SB(1, 0), b3, voffB); PG8_STAGE(PG8_SB(1, 1), b3 + hstepB, voffB); PG8_STAGE(PG8_SA(1, 0), a3, voffA);
            PG8_WAIT_V(8); PG8_WAIT_L(0); PG8_BAR; PG8_MMA(1, 0, At, B0); PG8_MMA(1, 1, At, B1); PG8_BAR; PG8_SCHED;
            } else {
            PG8_LDB(B0, 0, 0); PG8_SCHED; PG8_LDA(At, 0, 0); PG8_STAGE(PG8_SA(1, 1), a1 + hstepA, voffA);
            PG8_WAIT_L(8); PG8_BAR; PG8_WAIT_L(0); PG8_MMA(0, 0, At, B0); PG8_BAR; PG8_SCHED;
            PG8_LDB(B1, 0, 1); PG8_STAGE(PG8_SB(0, 0), b2, voffB);
            PG8_BAR; PG8_WAIT_L(0); PG8_MMA(0, 1, At, B1); PG8_BAR;
            PG8_LDA(At, 0, 1); PG8_STAGE(PG8_SA(0, 0), a2, voffA);
            PG8_BAR; PG8_WAIT_L(0); PG8_MMA(1, 0, At, B0); PG8_BAR; PG8_SCHED;
            PG8_STAGE(PG8_SB(0, 1), b2 + hstepB, voffB);
            PG8_WAIT_V(6); PG8_BAR; PG8_MMA(1, 1, At, B1); PG8_BAR;
            PG8_LDB(B0, 1, 0); PG8_SCHED; PG8_LDA(At, 1, 0); PG8_STAGE(PG8_SA(0, 1), a2 + hstepA, voffA);
            PG8_WAIT_L(8); PG8_BAR; PG8_WAIT_L(0); PG8_MMA(0, 0, At, B0); PG8_BAR; PG8_SCHED;
            PG8_LDB(B1, 1, 1); PG8_STAGE(PG8_SB(1, 0), b3, voffB);
            PG8_BAR; PG8_WAIT_L(0); PG8_MMA(0, 1, At, B1); PG8_BAR;
            PG8_LDA(At, 1, 1); PG8_STAGE(PG8_SA(1, 0), a3, voffA);
            PG8_BAR; PG8_WAIT_L(0); PG8_MMA(1, 0, At, B0); PG8_BAR; PG8_SCHED;
            PG8_STAGE(PG8_SB(1, 1), b3 + hstepB, voffB);
            PG8_WAIT_V(6); PG8_BAR; PG8_MMA(1, 1, At, B1); PG8_BAR;
            }
        }
        if constexpr (ALIGN_EPI) { if (wr == 0) PG8_BAR; }
        if constexpr (!Epi::AFTER_DRAIN) { E(acc, cur, wr, wc, fr, fq, lds + STAGE_BYTES); S.done(cur); }
        if (!has_next) break;
#pragma unroll
        for (int a = 0; a < 2; ++a)
#pragma unroll
            for (int b = 0; b < 2; ++b)
#pragma unroll
                for (int m = 0; m < 4; ++m)
#pragma unroll
                    for (int n = 0; n < 2; ++n) acc[a][b][m][n] = (f32x4){0.f, 0.f, 0.f, 0.f};
        cur = nxt; cA = nA; cB = nB; ++ui;
        if constexpr (ALIGN_EPI) { if (wr == 1) PG8_BAR; }
    }
    PG8_WAIT_V(0);
    if constexpr (!ALIGN_EPI) { if (wr == 0) PG8_BAR; }
    PG8_BAR;
    if constexpr (Epi::AFTER_DRAIN) { E.fused(acc, cur, wr, wc, fr, fq, lds, wid, lane); S.done(cur); }
#undef PG8_SA
#undef PG8_SB
#undef PG8_STAGE
#undef PG8_LDA
#undef PG8_LDB
#undef PG8_MMA
#undef PG8_WAIT_V
#undef PG8_WAIT_L
#undef PG8_BAR
#undef PG8_SCHED
}
}

constexpr size_t MiB = 1u << 20;
constexpr size_t WS_BT1 = 0;
constexpr size_t WS_BT2 = 44 * MiB;
constexpr size_t WS_BTQKV = 66 * MiB;
constexpr size_t WS_BTO = 71 * MiB;
constexpr size_t WS_BTP = 75 * MiB;
constexpr size_t WS_COS = 76 * MiB, WS_SIN = 80 * MiB;
constexpr size_t WS_SIDE = 84 * MiB;
constexpr size_t WS_XN = 96 * MiB;
constexpr size_t WS_T = 160 * MiB;
constexpr size_t WS_K = 224 * MiB, WS_VT = 240 * MiB;
constexpr size_t WS_A = 256 * MiB;
constexpr size_t WS_CTL = 432 * MiB, CTL_BYTES = 65536;
constexpr size_t WS_END = 433 * MiB;

constexpr int LDS_BYTES = 147456;
constexpr int NWAVES = 8;

struct Args {
    const float* x; const int* positions; const float* mix_pre_g; const float* mix_post_g; const float* pool_w; const float* pool_scale;
    const float* kv_norm_g; const float* w_kv; const float* w_q; const float* w_o; const float* sinks; const float* ffn_pre_g; const float* ffn_post_g;
    const float* ffn_w_in; const float* ffn_conv_w; const float* ffn_conv_b; const float* ffn_w_out;
    float* out; unsigned char* ws;
    float inv_freq[32];
    int ph_lo, ph_hi;
};

__device__ __forceinline__ float wave_sum(float v) {
#pragma unroll
    for (int o = 1; o < 64; o <<= 1) v += __shfl_xor(v, o);
    return v;
}

__device__ __forceinline__ void transpose_item(const float* W, int ldw, int k0, int n0, bf16_t* WT, int ldo, int orow0, const float* gk, const float* gn, float cst, LAS float* scr, int lane) {
#pragma unroll 8
    for (int i = 0; i < 32; ++i) { const int kk = 2 * i + (lane >> 5); float v = W[(size_t)(k0 + kk) * ldw + n0 + (lane & 31)]; if (gk) v *= gk[k0 + kk]; scr[kk * 33 + (lane & 31)] = v; }
    asm volatile("s_waitcnt lgkmcnt(0)" ::: "memory");
    const int c = lane & 7;
#pragma unroll
    for (int j = 0; j < 4; ++j) { const int n = (lane >> 3) + 8 * j; const LAS float* s = scr + (8 * c) * 33 + n;
        const float gg = (gn ? gn[n0 + n] : 1.0f) * cst;
        u32x4 o; o.x = pk2(s[0 * 33] * gg, s[1 * 33] * gg); o.y = pk2(s[2 * 33] * gg, s[3 * 33] * gg); o.z = pk2(s[4 * 33] * gg, s[5 * 33] * gg); o.w = pk2(s[6 * 33] * gg, s[7 * 33] * gg);
        *(u32x4*)(WT + (size_t)(orow0 + n) * ldo + k0 + 8 * c) = o; }
    asm volatile("s_waitcnt lgkmcnt(0)" ::: "memory");
}

__device__ __forceinline__ void row_phase(const float* xsrc, const bf16_t* t, const float* g, float* xdst, bf16_t* xn, int gw, int NGW, int lane) {
    f32x4 gv[4];
#pragma unroll
    for (int j = 0; j < 4; ++j) gv[j] = g ? *(const f32x4*)(g + 4 * lane + 256 * j) : (f32x4){0.f, 0.f, 0.f, 0.f};
    for (int m = gw; m < M; m += NGW) {
        f32x4 xv[4];
#pragma unroll
        for (int j = 0; j < 4; ++j) xv[j] = *(const f32x4*)(xsrc + (size_t)m * D + 4 * lane + 256 * j);
        if (t) {
            f32x4 tv[4]; float ss = 0.f;
#pragma unroll
            for (int j = 0; j < 4; ++j) { const u32x2 w = *(const u32x2*)(t + (size_t)m * D + 4 * lane + 256 * j);
                tv[j] = (f32x4){bf_lo(w.x), bf_hi(w.x), bf_lo(w.y), bf_hi(w.y)}; ss += (tv[j][0] * tv[j][0] + tv[j][1] * tv[j][1]) + (tv[j][2] * tv[j][2] + tv[j][3] * tv[j][3]); }
            const float rs = 1.0f / sqrtf(wave_sum(ss) * (1.0f / D) + RMS_EPS);
#pragma unroll
            for (int j = 0; j < 4; ++j) xv[j] += tv[j] * rs * gv[j];
        }
        if (xdst) {
#pragma unroll
            for (int j = 0; j < 4; ++j) *(f32x4*)(xdst + (size_t)m * D + 4 * lane + 256 * j) = xv[j];
        }
        if (xn) {
            float s2 = 0.f;
#pragma unroll
            for (int j = 0; j < 4; ++j) s2 += (xv[j][0] * xv[j][0] + xv[j][1] * xv[j][1]) + (xv[j][2] * xv[j][2] + xv[j][3] * xv[j][3]);
            const float r2 = 1.0f / sqrtf(wave_sum(s2) * (1.0f / D) + RMS_EPS);
#pragma unroll
            for (int j = 0; j < 4; ++j) { u32x2 w; w.x = pk2(xv[j][0] * r2, xv[j][1] * r2); w.y = pk2(xv[j][2] * r2, xv[j][3] * r2); *(u32x2*)(xn + (size_t)m * D + 4 * lane + 256 * j) = w; }
        }
    }
}

__device__ __forceinline__ void diff_phase(const bf16_t* xn, bf16_t* dd, int gw, int NGW, int lane) {
    for (int task = gw; task < (M / 2) * 4; task += NGW) {
        const int grp = task & 3, row = (task >> 2) * 2 + (lane >> 5), ts = row & (SEQ - 1), w = 2 << grp;
        const size_t off = (size_t)row * D + grp * 256 + 8 * (lane & 31);
        const u32x4 cur = *(const u32x4*)(xn + off);
        float acc[8] = {bf_lo(cur.x), bf_hi(cur.x), bf_lo(cur.y), bf_hi(cur.y), bf_lo(cur.z), bf_hi(cur.z), bf_lo(cur.w), bf_hi(cur.w)};
        float c0[8];
#pragma unroll
        for (int e = 0; e < 8; ++e) c0[e] = acc[e];
        for (int k = 1; k < w; ++k) {
            if (ts - k >= 0) { const u32x4 v = *(const u32x4*)(xn + off - (size_t)k * D);
                acc[0] += bf_lo(v.x); acc[1] += bf_hi(v.x); acc[2] += bf_lo(v.y); acc[3] += bf_hi(v.y); acc[4] += bf_lo(v.z); acc[5] += bf_hi(v.z); acc[6] += bf_lo(v.w); acc[7] += bf_hi(v.w); }
        }
        const float ic = 1.0f / (float)((ts + 1) < w ? (ts + 1) : w);
        u32x4 o; o.x = pk2(acc[0] * ic - c0[0], acc[1] * ic - c0[1]); o.y = pk2(acc[2] * ic - c0[2], acc[3] * ic - c0[3]);
        o.z = pk2(acc[4] * ic - c0[4], acc[5] * ic - c0[5]); o.w = pk2(acc[6] * ic - c0[6], acc[7] * ic - c0[7]);
        *(u32x4*)(dd + off) = o;
    }
}

__device__ __forceinline__ void fixup_phase(const float* side, const float* cw, const float* cb, bf16_t* Aout, int gtid, int NT) {
    for (int idx = gtid; idx < 128 * 2 * (FF / 4); idx += NT) {
        const int c = 4 * (idx % (FF / 4)), i = (idx / (FF / 4)) & 1, pm = idx / (2 * (FF / 4));
        const int sc = (c >> 7) * 256 + (c & 127);
        const f32x4 z = (f32x4){0.f, 0.f, 0.f, 0.f};
        const bool first = (pm & 15) == 0;
        const float* sp = side + (size_t)pm * 4 * FF2 + sc; const float* pp = sp - 4 * FF2;
        f32x4 o;
        {
            const f32x4 gm2 = first ? z : *(const f32x4*)(pp + 2 * FF2), gm1 = first ? z : *(const f32x4*)(pp + 3 * FF2), g0 = *(const f32x4*)(sp), g1 = *(const f32x4*)(sp + FF2);
            const f32x4 vm2 = first ? z : *(const f32x4*)(pp + 2 * FF2 + 128), vm1 = first ? z : *(const f32x4*)(pp + 3 * FF2 + 128), v0 = *(const f32x4*)(sp + 128), v1 = *(const f32x4*)(sp + FF2 + 128);
            const f32x4 wg0 = *(const f32x4*)(cw + c), wg1 = *(const f32x4*)(cw + FF2 + c), wg2 = *(const f32x4*)(cw + 2 * FF2 + c), bg = *(const f32x4*)(cb + c);
            const f32x4 wv0 = *(const f32x4*)(cw + FF + c), wv1 = *(const f32x4*)(cw + FF2 + FF + c), wv2 = *(const f32x4*)(cw + 2 * FF2 + FF + c), bv = *(const f32x4*)(cb + FF + c);
            const f32x4 cgv = (i == 0) ? (wg2 * g0 + wg1 * gm1 + wg0 * gm2 + bg) : (wg2 * g1 + wg1 * g0 + wg0 * gm1 + bg);
            const f32x4 cvv = (i == 0) ? (wv2 * v0 + wv1 * vm1 + wv0 * vm2 + bv) : (wv2 * v1 + wv1 * v0 + wv0 * vm1 + bv);
#pragma unroll
            for (int e = 0; e < 4; ++e) o[e] = gelu_tanh(cgv[e]) * cvv[e];
        }
        u32x2 w; w.x = pk2(o[0], o[1]); w.y = pk2(o[2], o[3]);
        *(u32x2*)(Aout + (size_t)(pm * 256 + i) * FF + c) = w;
    }
}

__device__ __forceinline__ void attn_phase(const bf16_t* Q, const bf16_t* Kb, const bf16_t* Vt, bf16_t* O, const float* sinks, int blk, int nblk, int wid, int lane) {
    const int q = lane & 31, hi = lane >> 5;
    for (int task = blk * 8 + wid; task < BATCH * 32 * 16 * 4; task += nblk * 8) {
        const int sb = task & 3, gq = (task >> 2) & 3, hk = (task >> 4) & 3, nb = (task >> 6) & 31, b = task >> 11;
        const int hq = hk * 4 + gq;
        const int row0 = b * SEQ + nb * 128 + sb * 32;
        const float sink2 = sinks[hq] * LOG2E;
        bf16x8 qf[4];
        { const bf16_t* qp = Q + (size_t)(row0 + q) * D + hq * 64 + hi * 8;
#pragma unroll
          for (int s = 0; s < 4; ++s) qf[s] = *(const bf16x8*)(qp + s * 16); }
        f32x16 st[5];
#pragma unroll
        for (int kbi = 0; kbi < 5; ++kbi) {
            int ks = nb * 128 - 128 + 32 * (sb + kbi);
            if (ks < 0) ks += 128;
            const bf16_t* kp = Kb + (size_t)(b * SEQ + ks + q) * 256 + hk * 64 + hi * 8;
            f32x16 a = {};
#pragma unroll
            for (int s = 0; s < 4; ++s) { const bf16x8 kf = *(const bf16x8*)(kp + s * 16); a = __builtin_amdgcn_mfma_f32_32x32x16_bf16(kf, qf[s], a, 0, 0, 0); }
            st[kbi] = a;
        }
        const float NEG = -1e30f;
#pragma unroll
        for (int kbi = 0; kbi < 5; ++kbi) {
            const bool dead = (nb == 0) && (sb + kbi < 4);
#pragma unroll
            for (int r = 0; r < 16; ++r) {
                const int kk = (r & 3) + 8 * (r >> 2) + 4 * hi;
                bool ok = !dead;
                if (kbi == 0) ok = ok && (kk > q);
                if (kbi == 4) ok = ok && (kk <= q);
                st[kbi][r] = ok ? st[kbi][r] : NEG;
            }
        }
        float mx = sink2;
#pragma unroll
        for (int kbi = 0; kbi < 5; ++kbi)
#pragma unroll
            for (int r = 0; r < 16; ++r) mx = fmaxf(mx, st[kbi][r]);
        mx = fmaxf(mx, __shfl_xor(mx, 32));
        float sum = 0.f;
        bf16x8 pw[5][2];
#pragma unroll
        for (int kbi = 0; kbi < 5; ++kbi) {
            float p[16];
#pragma unroll
            for (int r = 0; r < 16; ++r) { p[r] = __builtin_amdgcn_exp2f(st[kbi][r] - mx); sum += p[r]; }
#pragma unroll
            for (int h = 0; h < 2; ++h) { u32x4 w; w.x = pk2(p[8 * h + 0], p[8 * h + 1]); w.y = pk2(p[8 * h + 2], p[8 * h + 3]); w.z = pk2(p[8 * h + 4], p[8 * h + 5]); w.w = pk2(p[8 * h + 6], p[8 * h + 7]);
                pw[kbi][h] = __builtin_bit_cast(bf16x8, w); }
        }
        sum += __shfl_xor(sum, 32);
        const float inv = 1.0f / (sum + __builtin_amdgcn_exp2f(sink2 - mx));
        f32x16 ot[2]; ot[0] = f32x16{}; ot[1] = f32x16{};
#pragma unroll
        for (int kbi = 0; kbi < 5; ++kbi) {
            int ks = nb * 128 - 128 + 32 * (sb + kbi);
            if (ks < 0) ks += 128;
#pragma unroll
            for (int h = 0; h < 2; ++h)
#pragma unroll
                for (int dh = 0; dh < 2; ++dh) {
                    const bf16x8 vf = *(const bf16x8*)(Vt + ((size_t)((b * NKVH + hk) * HD + dh * 32 + q)) * SEQ + ks + h * 16 + hi * 8);
                    ot[dh] = __builtin_amdgcn_mfma_f32_32x32x16_bf16(vf, pw[kbi][h], ot[dh], 0, 0, 0);
                }
        }
        bf16_t* op = O + (size_t)(row0 + q) * D + hq * 64 + 4 * hi;
#pragma unroll
        for (int dh = 0; dh < 2; ++dh)
#pragma unroll
            for (int rg = 0; rg < 4; ++rg) { u32x2 w; w.x = pk2(ot[dh][4 * rg + 0] * inv, ot[dh][4 * rg + 1] * inv); w.y = pk2(ot[dh][4 * rg + 2] * inv, ot[dh][4 * rg + 3] * inv);
                *(u32x2*)(op + dh * 32 + 8 * rg) = w; }
    }
}

#define XB_TMO      128
#define XB_XCNT(j)  (256  + 64 * (j))
#define XB_XSUB(j)  (1280 + 64 * (j))
#define XB_XGEN(j)  (2304 + 64 * (j))
#define XB_TOP      3328
#define XB_TOPGEN   3392
#define XCD_BAR_WORDS 3456
#define XB_SPIN_CAP (1u << 18)

__device__ __forceinline__ unsigned xb_ld(unsigned* p)              { return __hip_atomic_load(p, __ATOMIC_RELAXED, __HIP_MEMORY_SCOPE_AGENT); }
__device__ __forceinline__ unsigned xb_add(unsigned* p, unsigned v) { return __hip_atomic_fetch_add(p, v, __ATOMIC_RELAXED, __HIP_MEMORY_SCOPE_AGENT); }
__device__ __forceinline__ unsigned xb_xcc_id() { return (unsigned)__builtin_amdgcn_s_getreg((3 << 11) | 20) & 0xFu; }
#define XB_SPIN(cond, bar) do { unsigned _sp = 0; while (cond) { __builtin_amdgcn_s_sleep(1); \
    if ((++_sp & 255u) == 0u) { if (xb_ld(&(bar)[XB_TMO])) break; if (_sp > XB_SPIN_CAP) { atomicAdd(&(bar)[XB_TMO], 1u); break; } } } } while (0)

struct XcdBarrier {
    unsigned* bar; unsigned x;
    volatile LAS unsigned* st;
};

__device__ __forceinline__ XcdBarrier xcd_barrier_post(unsigned* bar, volatile LAS unsigned* st) {
    XcdBarrier b; b.bar = bar; b.x = xb_xcc_id(); b.st = st;
    if (threadIdx.x == 0) (void)xb_add(&bar[XB_XCNT(b.x)], 1u);
    return b;
}
__device__ __forceinline__ void xcd_barrier_complete(unsigned* bar, unsigned x, unsigned& nloc, unsigned& nx) {
    const unsigned G = gridDim.x * gridDim.y * gridDim.z;
    unsigned sum, cnt, mine, sp = 0u;
    for (;;) {
        sum = 0u; cnt = 0u; mine = 0u;
#pragma unroll
        for (unsigned j = 0; j < 16; ++j) { const unsigned c = xb_ld(&bar[XB_XCNT(j)]); sum += c; cnt += (c > 0u) ? 1u : 0u; mine = (j == x) ? c : mine; }
        if (sum == G) break;
        __builtin_amdgcn_s_sleep(1);
        if ((++sp & 255u) == 0u) { if (xb_ld(&bar[XB_TMO])) break; if (sp > XB_SPIN_CAP) { atomicAdd(&bar[XB_TMO], 1u); break; } }
    }
    nloc = mine > 0u ? mine : 1u; nx = cnt > 0u ? cnt : 1u;
}

__device__ __forceinline__ void xcd_barrier(const XcdBarrier& b) {
    asm volatile("s_waitcnt vmcnt(0)" ::: "memory");
    __syncthreads();
    if (threadIdx.x == 0) {
        unsigned* bar = b.bar;
        __builtin_amdgcn_s_waitcnt(0);
        unsigned nloc = b.st[0], nx = b.st[1];
        if (nloc == 0u) { xcd_barrier_complete(bar, b.x, nloc, nx); b.st[0] = nloc; b.st[1] = nx; }
        const unsigned old = xb_add(&bar[XB_XSUB(b.x)], 1u);
        const unsigned gen = old / nloc;
        if (old + 1u == (gen + 1u) * nloc) {
            __builtin_amdgcn_fence(__ATOMIC_RELEASE, "agent");
            asm volatile("s_waitcnt vmcnt(0)" ::: "memory");
            const unsigned og = xb_add(&bar[XB_TOP], 1u);
            const unsigned tg = og / nx;
            if (og + 1u == (tg + 1u) * nx) xb_add(&bar[XB_TOPGEN], 1u);
            else XB_SPIN(xb_ld(&bar[XB_TOPGEN]) == tg, bar);
            __builtin_amdgcn_fence(__ATOMIC_ACQUIRE, "agent");
            xb_add(&bar[XB_XGEN(b.x)], 1u);
            asm volatile("s_waitcnt vmcnt(0)" ::: "memory");
        } else {
            XB_SPIN(xb_ld(&bar[XB_XGEN(b.x)]) == gen, bar);
            __builtin_amdgcn_fence(__ATOMIC_ACQUIRE, "agent");
            asm volatile("s_waitcnt vmcnt(0)" ::: "memory");
        }
    }
    __syncthreads();
}

enum { T_PRO = 0, T_ROWA, T_DIFF, T_POOLG, T_ROWB, T_QKV, T_ATTN, T_WO, T_GLU, T_FIX, T_DOWN };
constexpr int NPH = 31;
#ifndef PH_MASK
#define PH_MASK 0xFFFF
#endif
#define PH_ON(t) (((PH_MASK) >> (t)) & 1)
__host__ __device__ __forceinline__ void decode_phase(int ph, int& type, int& layer) {
    if (ph == 0) { type = T_PRO; layer = 0; return; }
    if (ph <= 6) { type = (int)((0xA98432ull >> (4 * (ph - 1))) & 15); layer = 0; return; }
    if (ph <= 13) { type = (int)((0xA984321ull >> (4 * (ph - 7))) & 15); layer = 1; return; }
    if (ph <= 29) { type = (int)((0xA9847651ull >> (4 * ((ph - 14) & 7))) & 15); layer = 2 + ((ph - 14) >> 3); return; }
    type = T_ROWA; layer = 4;
}

template <bool COOP>
__global__ void __launch_bounds__(NWAVES * 64, 2) yoco_fwd(Args a) {
    extern __shared__ __attribute__((aligned(16))) unsigned char lds_raw[];
    LAS unsigned char* lds = (LAS unsigned char*)lds_raw;
    const int G = gridDim.x, blk = blockIdx.x;
    const int wave_s = __builtin_amdgcn_readfirstlane(threadIdx.x >> 6);
    volatile LAS unsigned* MISC = (volatile LAS unsigned*)(lds + pg8::STAGE_BYTES + 8192);
    if (threadIdx.x < 16) MISC[threadIdx.x] = 0u;
    __syncthreads();
    XcdBarrier xbar; xbar.bar = (unsigned*)(a.ws + WS_CTL); xbar.x = 0; xbar.st = nullptr;
    if constexpr (COOP) xbar = xcd_barrier_post((unsigned*)(a.ws + WS_CTL), MISC + 8);
    int ph0 = a.ph_lo;
    if (PH_ON(T_PRO) && ph0 == 0) {
        int lane = __builtin_amdgcn_mbcnt_hi(~0u, __builtin_amdgcn_mbcnt_lo(~0u, 0u)); asm volatile("" : "+v"(lane));
        const int wave = wave_s, tid = wave * 64 + lane;
        const int gw = blk * NWAVES + wave, NGW = G * NWAVES;
        unsigned char* ws = a.ws; asm volatile("" : "+s"(ws));
        bf16_t* BT1 = (bf16_t*)(ws + WS_BT1); bf16_t* BT2 = (bf16_t*)(ws + WS_BT2); bf16_t* BTQKV = (bf16_t*)(ws + WS_BTQKV); bf16_t* BTO = (bf16_t*)(ws + WS_BTO); bf16_t* BTP = (bf16_t*)(ws + WS_BTP);
        float* COSB = (float*)(ws + WS_COS); float* SINB = (float*)(ws + WS_SIN); bf16_t* XN = (bf16_t*)(ws + WS_XN);
        {
            LAS float* scr = (LAS float*)(lds + wave * 16384);
            constexpr int I_IN = 16 * 176, I_OUT = 44 * 32, I_Q = 16 * 32, I_KV = 16 * 16, I_O = 16 * 32, I_P = 4 * 8;
            constexpr int NITEMS = 4 * I_IN + 4 * I_OUT + 2 * I_Q + I_KV + 2 * I_O + 8 * I_P;
            for (int it = gw; it < NITEMS; it += NGW) {
                int r = it;
                if (r < 4 * I_IN) { const int l = r / I_IN; r %= I_IN; const int kb = r / 176, nbk = r % 176, n0 = nbk * 32;
                    const int bj = n0 / FF, rem = n0 % FF, pn = rem / 128, j = rem % 128;
                    transpose_item(a.ffn_w_in + (size_t)l * D * FF2, FF2, kb * 64, n0, BT1 + (size_t)l * FF2 * D, D, pn * 256 + bj * 128 + j, a.ffn_pre_g + l * D, nullptr, 1.0f, scr, lane); continue; }
                r -= 4 * I_IN;
                if (r < 4 * I_OUT) { const int l = r / I_OUT; r %= I_OUT; const int kb = r / 32, nbk = r % 32;
                    transpose_item(a.ffn_w_out + (size_t)l * FF * D, D, kb * 64, nbk * 32, BT2 + (size_t)l * D * FF, FF, nbk * 32, nullptr, nullptr, 1.0f, scr, lane); continue; }
                r -= 4 * I_OUT;
                if (r < 2 * I_Q) { const int j2 = r / I_Q; r %= I_Q; const int kb = r / 32, nbk = r % 32, n0 = nbk * 32;
                    const int head = n0 >> 6, half = (n0 >> 5) & 1;
                    transpose_item(a.w_q + (size_t)j2 * D * D, D, kb * 64, n0, BTQKV + (size_t)j2 * NQKV * D, D, (head >> 2) * 256 + half * 128 + (head & 3) * 32, a.mix_pre_g + (2 + j2) * D, nullptr, 0.125f * LOG2E, scr, lane); continue; }
                r -= 2 * I_Q;
                if (r < I_KV) { const int kb = r / 16, nbk = r % 16, n0 = nbk * 32;
                    int orow; if (n0 < 256) { const int head = n0 >> 6, half = (n0 >> 5) & 1; orow = 1024 + half * 128 + head * 32; } else orow = 1280 + (n0 - 256);
                    transpose_item(a.w_kv, 512, kb * 64, n0, BTQKV, D, orow, a.kv_norm_g, nullptr, 1.0f, scr, lane); continue; }
                r -= I_KV;
                if (r < 2 * I_O) { const int j2 = r / I_O; r %= I_O; const int kb = r / 32, nbk = r % 32;
                    transpose_item(a.w_o + (size_t)j2 * D * D, D, kb * 64, nbk * 32, BTO + (size_t)j2 * D * D, D, nbk * 32, nullptr, nullptr, 1.0f, scr, lane); continue; }
                r -= 2 * I_O;
                { const int lg = r / I_P; r %= I_P; const int l = lg >> 2, grp = lg & 3, kb = r / 8, nbk = r % 8;
                    transpose_item(a.pool_w + (size_t)lg * 256 * 256, 256, kb * 64, nbk * 32, BTP + (size_t)l * D * 256, 256, grp * 256 + nbk * 32, a.mix_pre_g + l * D + grp * 256, a.pool_scale + l * D + grp * 256, 1.0f, scr, lane); }
            }
            for (int idx = blk * (NWAVES * 64) + tid; idx < M * 32; idx += G * NWAVES * 64) {
                const int row = idx >> 5, i = idx & 31;
                const float ang = (float)a.positions[row] * a.inv_freq[i];
                const double ad = (double)ang; const double kq = rint(ad * 0.63661977236758134308); const double rr = ad - kq * 1.57079632679489661923;
                const double r2 = rr * rr;
                const double sv = rr * (1.0 + r2 * (-1.0 / 6 + r2 * (1.0 / 120 + r2 * (-1.0 / 5040 + r2 * (1.0 / 362880 + r2 * (-1.0 / 39916800 + r2 * (1.0 / 6227020800.0)))))));
                const double cv = 1.0 + r2 * (-0.5 + r2 * (1.0 / 24 + r2 * (-1.0 / 720 + r2 * (1.0 / 40320 + r2 * (-1.0 / 3628800 + r2 * (1.0 / 479001600.0 + r2 * (-1.0 / 87178291200.0)))))));
                const int qd = ((int)kq) & 3;
                const double c = (qd == 0) ? cv : (qd == 1) ? -sv : (qd == 2) ? -cv : sv;
                const double s = (qd == 0) ? sv : (qd == 1) ? cv : (qd == 2) ? -sv : -cv;
                COSB[idx] = (float)c; SINB[idx] = (float)s;
            }
            row_phase(a.x, nullptr, nullptr, nullptr, XN, gw, NGW, lane);
        }
        ph0 = 1;
        if (ph0 < a.ph_hi) { if constexpr (COOP) { cg::this_grid().sync(); } }
    }
    for (int ph = ph0 < 1 ? 1 : ph0; ph < a.ph_hi; ++ph) {
        int type, layer; decode_phase(ph, type, layer);
        int lane = __builtin_amdgcn_mbcnt_hi(~0u, __builtin_amdgcn_mbcnt_lo(~0u, 0u)); asm volatile("" : "+v"(lane));
        const int wave = wave_s, tid = wave * 64 + lane;
        const int gw = blk * NWAVES + wave, NGW = G * NWAVES;
        unsigned char* ws = a.ws; asm volatile("" : "+s"(ws));
        bf16_t* BT1 = (bf16_t*)(ws + WS_BT1); bf16_t* BT2 = (bf16_t*)(ws + WS_BT2); bf16_t* BTQKV = (bf16_t*)(ws + WS_BTQKV); bf16_t* BTO = (bf16_t*)(ws + WS_BTO); bf16_t* BTP = (bf16_t*)(ws + WS_BTP);
        float* COSB = (float*)(ws + WS_COS); float* SINB = (float*)(ws + WS_SIN); float* SIDE = (float*)(ws + WS_SIDE);
        bf16_t* XN = (bf16_t*)(ws + WS_XN); bf16_t* TB = (bf16_t*)(ws + WS_T); bf16_t* KB = (bf16_t*)(ws + WS_K); bf16_t* VT = (bf16_t*)(ws + WS_VT);
        bf16_t* AB = (bf16_t*)(ws + WS_A); bf16_t* DB = AB; bf16_t* QO = AB;
        if (false) {
        } else if (PH_ON(T_ROWA) && type == T_ROWA) {
            row_phase(a.out, TB, a.ffn_post_g + (layer - 1) * D, a.out, layer < DEPTH ? XN : nullptr, gw, NGW, lane);
        } else if (PH_ON(T_ROWB) && type == T_ROWB) {
            row_phase(layer == 0 ? a.x : a.out, TB, a.mix_post_g + layer * D, a.out, XN, gw, NGW, lane);
        } else if (PH_ON(T_DIFF) && type == T_DIFF) {
            diff_phase(XN, DB, gw, NGW, lane);
        } else if (PH_ON(T_FIX) && type == T_FIX) {
            fixup_phase(SIDE, a.ffn_conv_w + (size_t)layer * 3 * FF2, a.ffn_conv_b + (size_t)layer * FF2, AB, blk * (NWAVES * 64) + tid, G * NWAVES * 64);
        } else if (PH_ON(T_ATTN) && type == T_ATTN) {
            attn_phase(QO, KB, VT, QO, a.sinks + (layer - 2) * NQH, blk, G, wave, lane);
        } else if (PH_ON(T_GLU) && type == T_GLU) {
            pg8::Gemm g{XN, BT1 + (size_t)layer * FF2 * D, D, D, D, 0}; pg8::StaticOrder S; S.init(M, FF2, G, blk);
            pg8::EpiGlu E{AB, a.ffn_conv_w + (size_t)layer * 3 * FF2, a.ffn_conv_b + (size_t)layer * FF2, SIDE};
            pg8::gemm_phase<pg8::EpiGlu, pg8::StaticOrder, true, true>(lds, g, S, E, tid);
        } else if (PH_ON(T_QKV) && type == T_QKV) {
            pg8::Gemm g{XN, BTQKV + (size_t)(layer - 2) * NQKV * D, D, D, D, 0}; pg8::StaticOrder S; S.init(M, layer == 2 ? NQKV : D, G, blk);
            pg8::EpiQKV E{QO, KB, VT, COSB, SINB};
            pg8::gemm_phase<pg8::EpiQKV, pg8::StaticOrder, true, true>(lds, g, S, E, tid);
        } else if (PH_ON(T_DOWN)) {
            pg8::Gemm g;
            if (type == T_POOLG) g = pg8::Gemm{DB, BTP + (size_t)layer * D * 256, D, 256, 256, 256};
            else if (type == T_WO) g = pg8::Gemm{QO, BTO + (size_t)(layer - 2) * D * D, D, D, D, 0};
            else g = pg8::Gemm{AB, BT2 + (size_t)layer * D * FF, FF, FF, FF, 0};
            pg8::StaticOrder S; S.init(M, D, G, blk);
            pg8::EpiBf16 E{TB, D};
            pg8::gemm_phase<pg8::EpiBf16, pg8::StaticOrder, true, true>(lds, g, S, E, tid);
        }
        if (ph + 1 < a.ph_hi) {
            if constexpr (COOP) { xcd_barrier(xbar); }
        }
    }
}

extern "C" void kernel_launch(void* const* d_in, const int* in_sizes, int n_in, void* d_out, int out_size, void* d_ws, size_t ws_size, hipStream_t stream) {
    static int grid = 0;
    static float invf[32];
    if (grid == 0) {
        if (n_in != 17 || out_size != M * D || ws_size < WS_END) { fprintf(stderr, "kernel_launch: unexpected shapes (n_in %d, out %d, ws %zu)\n", n_in, out_size, ws_size); grid = -1; return; }
        int dev = 0, cus = 0, per_cu = 0;
        (void)hipGetDevice(&dev); (void)hipDeviceGetAttribute(&cus, hipDeviceAttributeMultiprocessorCount, dev);
#if defined(MK_PER_PHASE)
        const void* kfn = (const void*)yoco_fwd<false>;
#else
        const void* kfn = (const void*)yoco_fwd<true>;
#endif
        (void)hipFuncSetAttribute(kfn, hipFuncAttributeMaxDynamicSharedMemorySize, LDS_BYTES);
        (void)hipOccupancyMaxActiveBlocksPerMultiprocessor(&per_cu, kfn, NWAVES * 64, LDS_BYTES);
        if (per_cu < 1) { fprintf(stderr, "kernel_launch: occupancy query says %d blocks per CU\n", per_cu); per_cu = 1; }
        (void)hipGetLastError();
        grid = cus * per_cu;
        for (int i = 0; i < 32; ++i) invf[i] = 1.0f / powf(10000.0f, (float)(2 * i) / 64.0f);
    }
    if (grid < 0) return;
    Args a{};
    a.x = (const float*)d_in[0]; a.positions = (const int*)d_in[1]; a.mix_pre_g = (const float*)d_in[2]; a.mix_post_g = (const float*)d_in[3]; a.pool_w = (const float*)d_in[4];
    a.pool_scale = (const float*)d_in[5]; a.kv_norm_g = (const float*)d_in[6]; a.w_kv = (const float*)d_in[7]; a.w_q = (const float*)d_in[8]; a.w_o = (const float*)d_in[9];
    a.sinks = (const float*)d_in[10]; a.ffn_pre_g = (const float*)d_in[11]; a.ffn_post_g = (const float*)d_in[12]; a.ffn_w_in = (const float*)d_in[13]; a.ffn_conv_w = (const float*)d_in[14];
    a.ffn_conv_b = (const float*)d_in[15]; a.ffn_w_out = (const float*)d_in[16];
    a.out = (float*)d_out; a.ws = (unsigned char*)d_ws;
    for (int i = 0; i < 32; ++i) a.inv_freq[i] = invf[i];
#if defined(MK_PER_PHASE)
    for (int ph = 0; ph < NPH; ++ph) { a.ph_lo = ph; a.ph_hi = ph + 1; hipLaunchKernelGGL(yoco_fwd<false>, dim3(grid), dim3(NWAVES * 64), LDS_BYTES, stream, a); }
#else
    a.ph_lo = 0; a.ph_hi = NPH;
    (void)hipMemsetAsync((char*)d_ws + WS_CTL, 0, CTL_BYTES, stream);
    void* args[] = {&a};
    hipError_t e = hipLaunchCooperativeKernel((const void*)yoco_fwd<true>, dim3(grid), dim3(NWAVES * 64), args, LDS_BYTES, stream);
    if (e != hipSuccess) fprintf(stderr, "cooperative launch failed: %s (grid %d)\n", hipGetErrorString(e), grid);
#endif
}
```

```cpp
#include <hip/hip_runtime.h>
#include <hip/hip_cooperative_groups.h>
#include <cstdio>
#include <cstdint>
#include <cmath>
namespace cg = cooperative_groups;

#define LAS __attribute__((address_space(3)))
#define PG8_LAS LAS
typedef unsigned short bf16_t;
typedef short bf16x8 __attribute__((ext_vector_type(8)));
typedef float f32x4 __attribute__((ext_vector_type(4)));
typedef float f32x16 __attribute__((ext_vector_type(16)));
typedef unsigned u32x4 __attribute__((ext_vector_type(4)));
typedef unsigned u32x2 __attribute__((ext_vector_type(2)));
typedef float f32x2_t __attribute__((ext_vector_type(2)));
typedef __bf16 bf16x2_t __attribute__((ext_vector_type(2)));

constexpr int D = 1024, BATCH = 8, SEQ = 4096, M = BATCH * SEQ, DEPTH = 4, NA = 2, FF = 2816, FF2 = 5632;
constexpr int HD = 64, NQH = 16, NKVH = 4, NQKV = 1536;
constexpr float RMS_EPS = 1e-6f;
constexpr float LOG2E = 1.4426950408889634f;

__device__ __forceinline__ unsigned pk2(float lo, float hi) { f32x2_t v = {lo, hi}; bf16x2_t b = __builtin_convertvector(v, bf16x2_t); return __builtin_bit_cast(unsigned, b); }
__device__ __forceinline__ float bf_lo(unsigned u) { return __builtin_bit_cast(float, u << 16); }
__device__ __forceinline__ float bf_hi(unsigned u) { return __builtin_bit_cast(float, u & 0xffff0000u); }
template <int CTRL> __device__ __forceinline__ float dppf(float old, float src) {
    return __builtin_bit_cast(float, __builtin_amdgcn_update_dpp(__builtin_bit_cast(int, old), __builtin_bit_cast(int, src), CTRL, 0xf, 0xf, false));
}
constexpr int DPP_SHR1 = 0x111, DPP_SHR2 = 0x112, DPP_ROR1 = 0x121, DPP_ROR2 = 0x122;
__device__ __forceinline__ float gelu_tanh(float x) {
    const float c1 = -2.0f * 0.7978845608028654f * LOG2E, c2 = c1 * 0.044715f;
    const float t = x * (c1 + c2 * x * x);
    const float e = __builtin_amdgcn_exp2f(t);
    return x * __builtin_amdgcn_rcpf(1.0f + e);
}

namespace pg8 {
constexpr int BM = 256, BK = 64, HALF = 128, HTB = HALF * BK * 2  , STAGE_BYTES = 8 * HTB, NXCD = 8, WGM = 8;
__host__ __device__ __forceinline__ int lds_byte(int r, int c) { const int st = (r >> 4) * 2 + (c >> 5), rr = r & 15, cc = c & 31, ob = rr * 64 + cc * 2; return st * 1024 + (ob ^ (((ob >> 9) & 1) << 5)); }
__host__ __device__ __forceinline__ void stage_rc(int b, int& R, int& C) { const int st = b / 1024, sb = b % 1024, swz = sb ^ (((sb >> 9) & 1) << 5); R = (st >> 1) * 16 + swz / 64; C = (st & 1) * 32 + (swz % 64) / 2; }
__host__ __device__ __forceinline__ int perm32(int rho) { const int n = rho >> 4, i = rho & 15; return 8 * (i >> 2) + 4 * n + (i & 3); }

struct Unit { int pm, pn; };
struct Gemm { const bf16_t* A; const bf16_t* Bt; int lda, ldb, K, acol; };

struct StaticOrder {
    int nM, nN, nwg, G, c;
    __host__ __device__ void init(int M_, int N_, int G_, int c_) { nM = M_ / BM; nN = N_ / BM; nwg = nM * nN; G = G_; c = c_; }
    __host__ __device__ bool next(int i, Unit& u) const {
        const long L = (long)i * G + c; if (L >= nwg) return false;
        int wgid = (int)L; { const int q = nwg / NXCD, r = nwg % NXCD, xcd = wgid % NXCD, off = wgid / NXCD; wgid = (xcd < r ? xcd * (q + 1) : r * (q + 1) + (xcd - r) * q) + off; }
        const int nig = WGM * nN, gid = wgid / nig, fm = gid * WGM, gsz = (nM - fm) < WGM ? (nM - fm) : WGM;
        u.pm = fm + ((wgid % nig) % gsz); u.pn = (wgid % nig) / gsz; return true;
    }
    __device__ __forceinline__ void a_ready(const Unit&) const {}
    __device__ __forceinline__ void done(const Unit&) const {}
};

struct EpiBf16 {
    static constexpr bool PERM = true, AFTER_DRAIN = false;
    bf16_t* O; int ldc;
    __device__ __forceinline__ void operator()(f32x4 (&acc)[2][2][4][2], const Unit& u, int wr, int wc, int fr, int fq, LAS unsigned char*) const {
        const int row0 = u.pm * BM + wr * 64 + fr, col0 = u.pn * BM + wc * 32 + 8 * fq;
#pragma unroll
        for (int ai = 0; ai < 2; ++ai)
#pragma unroll
            for (int m = 0; m < 4; ++m) { bf16_t* rowp = O + (size_t)(row0 + ai * HALF + m * 16) * ldc + col0;
#pragma unroll
                for (int bj = 0; bj < 2; ++bj) { const f32x4 v0 = acc[ai][bj][m][0], v1 = acc[ai][bj][m][1];
                    u32x4 w; w.x = pk2(v0[0], v0[1]); w.y = pk2(v0[2], v0[3]); w.z = pk2(v1[0], v1[1]); w.w = pk2(v1[2], v1[3]);
                    *(u32x4*)(rowp + bj * HALF) = w; } }
    }
};

struct EpiQKV {
    static constexpr bool PERM = true, AFTER_DRAIN = false;
    bf16_t* Q; bf16_t* Kb; bf16_t* Vt; const float* cs; const float* sn;
    __device__ __forceinline__ void operator()(f32x4 (&acc)[2][2][4][2], const Unit& u, int wr, int wc, int fr, int fq, LAS unsigned char*) const {
        if (u.pn <= 4) {
            bf16_t* base; int ld, head;
            if (u.pn < 4) { base = Q; ld = D; head = u.pn * 4 + wc; } else { base = Kb; ld = 256; head = wc; }
#pragma unroll
            for (int ai = 0; ai < 2; ++ai)
#pragma unroll
                for (int m = 0; m < 4; ++m) {
                    const int row = u.pm * BM + ai * HALF + wr * 64 + m * 16 + fr;
                    const float* cp = cs + (size_t)row * 32 + 8 * fq; const float* sp = sn + (size_t)row * 32 + 8 * fq;
                    u32x4 w1, w2;
#pragma unroll
                    for (int n = 0; n < 2; ++n) {
                        const f32x4 c = *(const f32x4*)(cp + 4 * n), s = *(const f32x4*)(sp + 4 * n);
                        const f32x4 x1 = acc[ai][0][m][n], x2 = acc[ai][1][m][n];
                        const f32x4 o1 = x1 * c - x2 * s, o2 = x2 * c + x1 * s;
                        if (n == 0) { w1.x = pk2(o1[0], o1[1]); w1.y = pk2(o1[2], o1[3]); w2.x = pk2(o2[0], o2[1]); w2.y = pk2(o2[2], o2[3]); }
                        else        { w1.z = pk2(o1[0], o1[1]); w1.w = pk2(o1[2], o1[3]); w2.z = pk2(o2[0], o2[1]); w2.w = pk2(o2[2], o2[3]); }
                    }
                    bf16_t* op = base + (size_t)row * ld + head * 64 + 8 * fq;
                    *(u32x4*)op = w1; *(u32x4*)(op + 32) = w2;
                }
        } else {
            const int pos = (fr & 3) + 4 * ((fr >> 3) & 1) + 8 * ((fr >> 2) & 1);
#pragma unroll
            for (int ai = 0; ai < 2; ++ai)
#pragma unroll
                for (int m = 0; m < 4; ++m) {
                    const int row = u.pm * BM + ai * HALF + wr * 64 + m * 16;
                    const int b = row >> 12, s = (row & 4095) + pos;
#pragma unroll
                    for (int bj = 0; bj < 2; ++bj)
#pragma unroll
                        for (int n = 0; n < 2; ++n)
#pragma unroll
                            for (int e = 0; e < 4; ++e) {
                                const int c = bj * HALF + wc * 32 + 8 * fq + 4 * n + e, hk = c >> 6, d = c & 63;
                                Vt[((size_t)((b * NKVH + hk) * HD + d)) * SEQ + s] = (bf16_t)(pk2(acc[ai][bj][m][n][e], 0.f) & 0xffffu);
                            }
                }
        }
    }
};

struct EpiGlu {
    static constexpr bool PERM = true, AFTER_DRAIN = false;
    bf16_t* Aout; const float* cw; const float* cb; float* side;
    __device__ __forceinline__ void operator()(f32x4 (&acc)[2][2][4][2], const Unit& u, int wr, int wc, int fr, int fq, LAS unsigned char* xl) const {
        LAS f32x4* X = (LAS f32x4*)xl;
        const int tc0 = wc * 32 + 8 * fq;
        if (fr >= 14) {
#pragma unroll
            for (int ai = 0; ai < 2; ++ai)
#pragma unroll
                for (int bj = 0; bj < 2; ++bj)
#pragma unroll
                    for (int n = 0; n < 2; ++n) X[((ai * 2 + wr) * 2 + (fr - 14)) * 64 + ((bj * HALF + tc0 + 4 * n) >> 2)] = acc[ai][bj][3][n];
        }
        if (wr == 0 && fr < 2) {
#pragma unroll
            for (int bj = 0; bj < 2; ++bj)
#pragma unroll
                for (int n = 0; n < 2; ++n) *(f32x4*)(side + ((size_t)(u.pm * 4 + fr)) * FF2 + u.pn * 256 + bj * HALF + tc0 + 4 * n) = acc[0][bj][0][n];
        }
        if (wr == 1 && fr >= 14) {
#pragma unroll
            for (int bj = 0; bj < 2; ++bj)
#pragma unroll
                for (int n = 0; n < 2; ++n) *(f32x4*)(side + ((size_t)(u.pm * 4 + 2 + (fr - 14))) * FF2 + u.pn * 256 + bj * HALF + tc0 + 4 * n) = acc[1][bj][3][n];
        }
        asm volatile("s_waitcnt lgkmcnt(0)" ::: "memory"); __builtin_amdgcn_s_barrier(); asm volatile("" ::: "memory");
        const int row0 = u.pm * BM + wr * 64 + fr;
#pragma unroll
        for (int n = 0; n < 2; ++n) {
            const int c0 = u.pn * 128 + tc0 + 4 * n;
            const f32x4 wg0 = *(const f32x4*)(cw + c0), wg1 = *(const f32x4*)(cw + FF2 + c0), wg2 = *(const f32x4*)(cw + 2 * FF2 + c0), bg = *(const f32x4*)(cb + c0);
            const f32x4 wv0 = *(const f32x4*)(cw + FF + c0), wv1 = *(const f32x4*)(cw + FF2 + FF + c0), wv2 = *(const f32x4*)(cw + 2 * FF2 + FF + c0), bv = *(const f32x4*)(cb + FF + c0);
#pragma unroll
            for (int ai = 0; ai < 2; ++ai) {
                const int sidx = ai * 2 + wr;
                f32x4 hg = (f32x4){0.f, 0.f, 0.f, 0.f}, hv = hg;
                if (sidx > 0) { hg = X[((sidx - 1) * 2 + (fr & 1)) * 64 + ((tc0 + 4 * n) >> 2)]; hv = X[((sidx - 1) * 2 + (fr & 1)) * 64 + ((HALF + tc0 + 4 * n) >> 2)]; }
                f32x4 p1g, p2g, p1v, p2v;
#pragma unroll
                for (int e = 0; e < 4; ++e) { p1g[e] = dppf<DPP_ROR1>(hg[e], hg[e]); p2g[e] = dppf<DPP_ROR2>(hg[e], hg[e]); p1v[e] = dppf<DPP_ROR1>(hv[e], hv[e]); p2v[e] = dppf<DPP_ROR2>(hv[e], hv[e]); }
#pragma unroll
                for (int m = 0; m < 4; ++m) {
                    const f32x4 g = acc[ai][0][m][n], v = acc[ai][1][m][n];
                    f32x4 o;
#pragma unroll
                    for (int e = 0; e < 4; ++e) {
                        const float g1 = dppf<DPP_SHR1>(p1g[e], g[e]), g2 = dppf<DPP_SHR2>(p2g[e], g[e]);
                        const float v1 = dppf<DPP_SHR1>(p1v[e], v[e]), v2 = dppf<DPP_SHR2>(p2v[e], v[e]);
                        p1g[e] = dppf<DPP_ROR1>(g[e], g[e]); p2g[e] = dppf<DPP_ROR2>(g[e], g[e]);
                        p1v[e] = dppf<DPP_ROR1>(v[e], v[e]); p2v[e] = dppf<DPP_ROR2>(v[e], v[e]);
                        const float cgv = wg2[e] * g[e] + wg1[e] * g1 + wg0[e] * g2 + bg[e];
                        const float cvv = wv2[e] * v[e] + wv1[e] * v1 + wv0[e] * v2 + bv[e];
                        o[e] = gelu_tanh(cgv) * cvv;
                    }
                    u32x2 w; w.x = pk2(o[0], o[1]); w.y = pk2(o[2], o[3]);
                    *(u32x2*)(Aout + (size_t)(row0 + ai * HALF + m * 16) * FF + u.pn * 128 + tc0 + 4 * n) = w;
                }
                __builtin_amdgcn_sched_barrier(0);
            }
        }
    }
};

template <class Epi, class Sched, bool ALIGN_EPI = false, bool SP2 = false>
__device__ __forceinline__ void gemm_phase(PG8_LAS unsigned char* lds, const Gemm g, const Sched& S, const Epi& E, const int tid) {
    const int wid = __builtin_amdgcn_readfirstlane(tid >> 6), lane = tid & 63, wr = wid >> 2, wc = wid & 3, fr = lane & 15, fq = lane >> 4;
    const int K = g.K, nt = K / BK;
    unsigned voffA[2], voffB[2];
#pragma unroll
    for (int i = 0; i < 2; ++i) { int R, C; stage_rc(tid * 16 + i * 8192, R, C); const int Rb = Epi::PERM ? ((R & ~31) + perm32(R & 31)) : R;
        voffA[i] = (unsigned)(R * g.lda + C) * 2u; voffB[i] = (unsigned)(Rb * g.ldb + C) * 2u; }
    const size_t kstep = (size_t)(BK * 2);
    const size_t hstepA = (size_t)HALF * g.lda * 2, hstepB = (size_t)HALF * g.ldb * 2;
    const size_t tstepA = 2 * hstepA, tstepB = 2 * hstepB;
    const unsigned ldsw = (unsigned)wid * 1024u;
    const int aoff = lds_byte(wr * 64 + fr, fq * 8), boff = lds_byte(wc * 32 + fr, fq * 8);
#define PG8_SA(b, h) (((b) * 2 + (h)) * HTB)
#define PG8_SB(b, h) ((4 + (b) * 2 + (h)) * HTB)
#define PG8_STAGE(bufoff, gbase, voff) do { _Pragma("unroll") for (int _i = 0; _i < 2; ++_i) \
        __builtin_amdgcn_global_load_lds((const unsigned*)((const char*)(gbase) + (voff)[_i]), (PG8_LAS unsigned*)(lds + (bufoff) + ldsw + _i * 8192), 16, 0, 0); } while (0)
#define PG8_LDA(dst, b, h) do { _Pragma("unroll") for (int m = 0; m < 4; ++m) _Pragma("unroll") for (int k = 0; k < 2; ++k) dst[m][k] = *(const PG8_LAS bf16x8*)(lds + PG8_SA(b, h) + aoff + m * 2048 + k * 1024); } while (0)
#define PG8_LDB(dst, b, h) do { _Pragma("unroll") for (int n = 0; n < 2; ++n) _Pragma("unroll") for (int k = 0; k < 2; ++k) dst[n][k] = *(const PG8_LAS bf16x8*)(lds + PG8_SB(b, h) + boff + n * 2048 + k * 1024); } while (0)
#define PG8_MMA(ai, bj, At, Bt) do { __builtin_amdgcn_s_setprio(1); _Pragma("unroll") for (int m = 0; m < 4; ++m) _Pragma("unroll") for (int n = 0; n < 2; ++n) _Pragma("unroll") for (int k = 0; k < 2; ++k) \
        acc[ai][bj][m][n] = __builtin_amdgcn_mfma_f32_16x16x32_bf16(Bt[n][k], At[m][k], acc[ai][bj][m][n], 0, 0, 0); __builtin_amdgcn_s_setprio(0); } while (0)
#define PG8_WAIT_V(n) asm volatile("s_waitcnt vmcnt(" #n ")" ::: "memory")
#define PG8_WAIT_L(n) asm volatile("s_waitcnt lgkmcnt(" #n ")" ::: "memory")
#define PG8_BAR __builtin_amdgcn_s_barrier()
#define PG8_SCHED __builtin_amdgcn_sched_barrier(0)
    Unit cur, nxt; int ui = 0;
    if (!S.next(0, cur)) return;
    f32x4 acc[2][2][4][2];
#pragma unroll
    for (int a = 0; a < 2; ++a)
#pragma unroll
        for (int b = 0; b < 2; ++b)
#pragma unroll
            for (int m = 0; m < 4; ++m)
#pragma unroll
                for (int n = 0; n < 2; ++n) acc[a][b][m][n] = (f32x4){0.f, 0.f, 0.f, 0.f};
    bf16x8 At[4][2], B0[2][2], B1[2][2];
    const char* cA = (const char*)g.A + (size_t)cur.pm * tstepA + (size_t)cur.pn * g.acol * 2; const char* cB = (const char*)g.Bt + (size_t)cur.pn * tstepB;
    S.a_ready(cur);
    if constexpr (SP2) {
        PG8_STAGE(PG8_SB(0, 0), cB, voffB); PG8_STAGE(PG8_SB(0, 1), cB + hstepB, voffB); PG8_STAGE(PG8_SA(0, 0), cA, voffA); PG8_STAGE(PG8_SA(0, 1), cA + hstepA, voffA);
        if (wr == 1) PG8_BAR;
        PG8_WAIT_V(2); PG8_BAR;
        PG8_STAGE(PG8_SB(1, 0), cB + kstep, voffB); PG8_STAGE(PG8_SA(1, 0), cA + kstep, voffA); PG8_STAGE(PG8_SB(1, 1), cB + hstepB + kstep, voffB);
        PG8_WAIT_V(6); PG8_BAR;
    } else {
        PG8_STAGE(PG8_SB(0, 0), cB, voffB); PG8_STAGE(PG8_SA(0, 0), cA, voffA); PG8_STAGE(PG8_SB(0, 1), cB + hstepB, voffB); PG8_STAGE(PG8_SA(0, 1), cA + hstepA, voffA);
        if (wr == 1) PG8_BAR;
        PG8_WAIT_V(4); PG8_BAR;
        PG8_STAGE(PG8_SB(1, 0), cB + kstep, voffB); PG8_STAGE(PG8_SA(1, 0), cA + kstep, voffA); PG8_STAGE(PG8_SB(1, 1), cB + hstepB + kstep, voffB);
        PG8_WAIT_V(6); PG8_BAR;
    }
    for (;;) {
        const bool has_next = S.next(ui + 1, nxt);
        const char* nA = has_next ? (const char*)g.A + (size_t)nxt.pm * tstepA + (size_t)nxt.pn * g.acol * 2 : cA; const char* nB = has_next ? (const char*)g.Bt + (size_t)nxt.pn * tstepB : cB;
        for (int t = 0; t < nt; t += 2) {
            const bool last = (t == nt - 2);
            const char* a1 = cA + (size_t)(t + 1) * kstep;
            const char* a2 = last ? nA : cA + (size_t)(t + 2) * kstep; const char* b2 = last ? nB : cB + (size_t)(t + 2) * kstep;
            const char* a3 = a2 + kstep; const char* b3 = b2 + kstep;
            if (last && has_next) S.a_ready(nxt);
            if constexpr (SP2) {
            PG8_LDB(B0, 0, 0); PG8_LDB(B1, 0, 1); PG8_SCHED; PG8_LDA(At, 0, 0); PG8_STAGE(PG8_SA(1, 1), a1 + hstepA, voffA);
            PG8_WAIT_V(8); PG8_WAIT_L(0); PG8_BAR; PG8_MMA(0, 0, At, B0); PG8_MMA(0, 1, At, B1); PG8_BAR; PG8_SCHED;
            PG8_LDA(At, 0, 1); PG8_STAGE(PG8_SB(0, 0), b2, voffB); PG8_STAGE(PG8_SB(0, 1), b2 + hstepB, voffB); PG8_STAGE(PG8_SA(0, 0), a2, voffA);
            PG8_WAIT_V(8); PG8_WAIT_L(0); PG8_BAR; PG8_MMA(1, 0, At, B0); PG8_MMA(1, 1, At, B1); PG8_BAR; PG8_SCHED;
            PG8_LDB(B0, 1, 0); PG8_LDB(B1, 1, 1); PG8_SCHED; PG8_LDA(At, 1, 0); PG8_STAGE(PG8_SA(0, 1), a2 + hstepA, voffA);
            PG8_WAIT_V(8); PG8_WAIT_L(0); PG8_BAR; PG8_MMA(0, 0, At, B0); PG8_MMA(0, 1, At, B1); PG8_BAR; PG8_SCHED;
            PG8_LDA(At, 1, 1); PG8_STAGE(PG8_SB(1, 0), b3, voffB); PG8_STAGE(PG8_SB(1, 1), b3 + hstepB, voffB); PG8_STAGE(PG8_SA(1, 0), a3, voffA);
            PG8_WAIT_V(8); PG8_WAIT_L(0); PG8_BAR; PG8_MMA(1, 0, At, B0); PG8_MMA(1, 1, At, B1); PG8_BAR; PG8_SCHED;
            } else {
            PG8_LDB(B0, 0, 0); PG8_SCHED; PG8_LDA(At, 0, 0); PG8_STAGE(PG8_SA(1, 1), a1 + hstepA, voffA);
            PG8_WAIT_L(8); PG8_BAR; PG8_WAIT_L(0); PG8_MMA(0, 0, At, B0); PG8_BAR; PG8_SCHED;
            PG8_LDB(B1, 0, 1); PG8_STAGE(PG8_SB(0, 0), b2, voffB);
            PG8_BAR; PG8_WAIT_L(0); PG8_MMA(0, 1, At, B1); PG8_BAR;
            PG8_LDA(At, 0, 1); PG8_STAGE(PG8_SA(0, 0), a2, voffA);
            PG8_BAR; PG8_WAIT_L(0); PG8_MMA(1, 0, At, B0); PG8_BAR; PG8_SCHED;
            PG8_STAGE(PG8_SB(0, 1), b2 + hstepB, voffB);
            PG8_WAIT_V(6); PG8_BAR; PG8_MMA(1, 1, At, B1); PG8_BAR;
            PG8_LDB(B0, 1, 0); PG8_SCHED; PG8_LDA(At, 1, 0); PG8_STAGE(PG8_SA(0, 1), a2 + hstepA, voffA);
            PG8_WAIT_L(8); PG8_BAR; PG8_WAIT_L(0); PG8_MMA(0, 0, At, B0); PG8_BAR; PG8_SCHED;
            PG8_LDB(B1, 1, 1); PG8_STAGE(PG8_SB(1, 0), b3, voffB);
            PG8_BAR; PG8_WAIT_L(0); PG8_MMA(0, 1, At, B1); PG8_BAR;
            PG8_LDA(At, 1, 1); PG8_STAGE(PG8_SA(1, 0), a3, voffA);
            PG8_BAR; PG8_WAIT_L(0); PG8_MMA(1, 0, At, B0); PG8_BAR; PG8_SCHED;
            PG8_STAGE(PG8_SB(1, 1), b3 + hstepB, voffB);
            PG8_WAIT_V(6); PG8_BAR; PG8_MMA(1, 1, At, B1); PG8_BAR;
            }
        }
        if constexpr (ALIGN_EPI) { if (wr == 0) PG8_BAR; }
        if constexpr (!Epi::AFTER_DRAIN) { E(acc, cur, wr, wc, fr, fq, lds + STAGE_BYTES); S.done(cur); }
        if (!has_next) break;
#pragma unroll
        for (int a = 0; a < 2; ++a)
#pragma unroll
            for (int b = 0; b < 2; ++b)
#pragma unroll
                for (int m = 0; m < 4; ++m)
#pragma unroll
                    for (int n = 0; n < 2; ++n) acc[a][b][m][n] = (f32x4){0.f, 0.f, 0.f, 0.f};
        cur = nxt; cA = nA; cB = nB; ++ui;
        if constexpr (ALIGN_EPI) { if (wr == 1) PG8_BAR; }
    }
    PG8_WAIT_V(0);
    if constexpr (!ALIGN_EPI) { if (wr == 0) PG8_BAR; }
    PG8_BAR;
    if constexpr (Epi::AFTER_DRAIN) { E.fused(acc, cur, wr, wc, fr, fq, lds, wid, lane); S.done(cur); }
#undef PG8_SA
#undef PG8_SB
#undef PG8_STAGE
#undef PG8_LDA
#undef PG8_LDB
#undef PG8_MMA
#undef PG8_WAIT_V
#undef PG8_WAIT_L
#undef PG8_BAR
#undef PG8_SCHED
}
}

constexpr size_t MiB = 1u << 20;
constexpr size_t WS_BT1 = 0;
constexpr size_t WS_BT2 = 44 * MiB;
constexpr size_t WS_BTQKV = 66 * MiB;
constexpr size_t WS_BTO = 71 * MiB;
constexpr size_t WS_BTP = 75 * MiB;
constexpr size_t WS_COS = 76 * MiB, WS_SIN = 80 * MiB;
constexpr size_t WS_SIDE = 84 * MiB;
constexpr size_t WS_XN = 96 * MiB;
constexpr size_t WS_T = 160 * MiB;
constexpr size_t WS_K = 224 * MiB, WS_VT = 240 * MiB;
constexpr size_t WS_A = 256 * MiB;
constexpr size_t WS_CTL = 432 * MiB, CTL_BYTES = 65536;
constexpr size_t WS_END = 433 * MiB;

constexpr int LDS_BYTES = 147456;
constexpr int NWAVES = 8;

struct Args {
    const float* x; const int* positions; const float* mix_pre_g; const float* mix_post_g; const float* pool_w; const float* pool_scale;
    const float* kv_norm_g; const float* w_kv; const float* w_q; const float* w_o; const float* sinks; const float* ffn_pre_g; const float* ffn_post_g;
    const float* ffn_w_in; const float* ffn_conv_w; const float* ffn_conv_b; const float* ffn_w_out;
    float* out; unsigned char* ws;
    float inv_freq[32];
    int ph_lo, ph_hi;
};

__device__ __forceinline__ float wave_sum(float v) {
#pragma unroll
    for (int o = 1; o < 64; o <<= 1) v += __shfl_xor(v, o);
    return v;
}

__device__ __forceinline__ void transpose_item(const float* W, int ldw, int k0, int n0, bf16_t* WT, int ldo, int orow0, const float* gk, const float* gn, float cst, LAS float* scr, int lane) {
#pragma unroll 8
    for (int i = 0; i < 32; ++i) { const int kk = 2 * i + (lane >> 5); float v = W[(size_t)(k0 + kk) * ldw + n0 + (lane & 31)]; if (gk) v *= gk[k0 + kk]; scr[kk * 33 + (lane & 31)] = v; }
    asm volatile("s_waitcnt lgkmcnt(0)" ::: "memory");
    const int c = lane & 7;
#pragma unroll
    for (int j = 0; j < 4; ++j) { const int n = (lane >> 3) + 8 * j; const LAS float* s = scr + (8 * c) * 33 + n;
        const float gg = (gn ? gn[n0 + n] : 1.0f) * cst;
        u32x4 o; o.x = pk2(s[0 * 33] * gg, s[1 * 33] * gg); o.y = pk2(s[2 * 33] * gg, s[3 * 33] * gg); o.z = pk2(s[4 * 33] * gg, s[5 * 33] * gg); o.w = pk2(s[6 * 33] * gg, s[7 * 33] * gg);
        *(u32x4*)(WT + (size_t)(orow0 + n) * ldo + k0 + 8 * c) = o; }
    asm volatile("s_waitcnt lgkmcnt(0)" ::: "memory");
}

__device__ __forceinline__ void row_phase(const float* xsrc, const bf16_t* t, const float* g, float* xdst, bf16_t* xn, int gw, int NGW, int lane) {
    f32x4 gv[4];
#pragma unroll
    for (int j = 0; j < 4; ++j) gv[j] = g ? *(const f32x4*)(g + 4 * lane + 256 * j) : (f32x4){0.f, 0.f, 0.f, 0.f};
    f32x4 xv[4], xnx[4]; u32x2 tw[4], tnx[4];
    if (gw < M) {
#pragma unroll
        for (int j = 0; j < 4; ++j) { xv[j] = *(const f32x4*)(xsrc + (size_t)gw * D + 4 * lane + 256 * j); tw[j] = t ? *(const u32x2*)(t + (size_t)gw * D + 4 * lane + 256 * j) : (u32x2){0u, 0u}; }
    }
    for (int m = gw; m < M; m += NGW) {
        const int mn = m + NGW;
        if (mn < M) {
#pragma unroll
            for (int j = 0; j < 4; ++j) { xnx[j] = *(const f32x4*)(xsrc + (size_t)mn * D + 4 * lane + 256 * j); tnx[j] = t ? *(const u32x2*)(t + (size_t)mn * D + 4 * lane + 256 * j) : (u32x2){0u, 0u}; }
        }
        if (t) {
            f32x4 tv[4]; float ss = 0.f;
#pragma unroll
            for (int j = 0; j < 4; ++j) { const u32x2 w = tw[j];
                tv[j] = (f32x4){bf_lo(w.x), bf_hi(w.x), bf_lo(w.y), bf_hi(w.y)}; ss += (tv[j][0] * tv[j][0] + tv[j][1] * tv[j][1]) + (tv[j][2] * tv[j][2] + tv[j][3] * tv[j][3]); }
            const float rs = 1.0f / sqrtf(wave_sum(ss) * (1.0f / D) + RMS_EPS);
#pragma unroll
            for (int j = 0; j < 4; ++j) xv[j] += tv[j] * rs * gv[j];
        }
        if (xdst) {
#pragma unroll
            for (int j = 0; j < 4; ++j) *(f32x4*)(xdst + (size_t)m * D + 4 * lane + 256 * j) = xv[j];
        }
        if (xn) {
            float s2 = 0.f;
#pragma unroll
            for (int j = 0; j < 4; ++j) s2 += (xv[j][0] * xv[j][0] + xv[j][1] * xv[j][1]) + (xv[j][2] * xv[j][2] + xv[j][3] * xv[j][3]);
            const float r2 = 1.0f / sqrtf(wave_sum(s2) * (1.0f / D) + RMS_EPS);
#pragma unroll
            for (int j = 0; j < 4; ++j) { u32x2 w; w.x = pk2(xv[j][0] * r2, xv[j][1] * r2); w.y = pk2(xv[j][2] * r2, xv[j][3] * r2); *(u32x2*)(xn + (size_t)m * D + 4 * lane + 256 * j) = w; }
        }
#pragma unroll
        for (int j = 0; j < 4; ++j) { xv[j] = xnx[j]; tw[j] = tnx[j]; }
    }
}

__device__ __forceinline__ void add8(float (&a)[8], const u32x4 v, float sgn) {
    a[0] += sgn * bf_lo(v.x); a[1] += sgn * bf_hi(v.x); a[2] += sgn * bf_lo(v.y); a[3] += sgn * bf_hi(v.y); a[4] += sgn * bf_lo(v.z); a[5] += sgn * bf_hi(v.z); a[6] += sgn * bf_lo(v.w); a[7] += sgn * bf_hi(v.w);
}
__device__ __forceinline__ void diff_phase(const bf16_t* xn, bf16_t* dd, int gtid, int NT) {
    for (int item = gtid; item < (M / 32) * 128; item += NT) {
        const int c = item & 127, t0 = (item >> 7) * 32, ts0 = t0 & (SEQ - 1), grp = c >> 5, w = 2 << grp;
        const bf16_t* base = xn + (size_t)t0 * D + 8 * c;
        float S[8] = {0.f, 0.f, 0.f, 0.f, 0.f, 0.f, 0.f, 0.f};
#pragma unroll
        for (int k = 1; k < 16; ++k) { if (k < w && ts0 - k >= 0) add8(S, *(const u32x4*)(base - (size_t)k * D), 1.0f); }
#pragma unroll 1
        for (int i0 = 0; i0 < 32; i0 += 8) {
            u32x4 cur[8], old[8];
#pragma unroll
            for (int i = 0; i < 8; ++i) { cur[i] = *(const u32x4*)(base + (size_t)(i0 + i) * D);
                old[i] = (i0 + i > 0 && ts0 + i0 + i - w >= 0) ? *(const u32x4*)(base + (size_t)(i0 + i - w) * D) : (u32x4){0u, 0u, 0u, 0u}; }
#pragma unroll
            for (int i = 0; i < 8; ++i) {
                if (i0 + i > 0) add8(S, old[i], -1.0f);
                add8(S, cur[i], 1.0f);
                const int ts = ts0 + i0 + i; const float ic = 1.0f / (float)((ts + 1) < w ? (ts + 1) : w);
                const u32x4 v = cur[i];
                u32x4 o; o.x = pk2(S[0] * ic - bf_lo(v.x), S[1] * ic - bf_hi(v.x)); o.y = pk2(S[2] * ic - bf_lo(v.y), S[3] * ic - bf_hi(v.y));
                o.z = pk2(S[4] * ic - bf_lo(v.z), S[5] * ic - bf_hi(v.z)); o.w = pk2(S[6] * ic - bf_lo(v.w), S[7] * ic - bf_hi(v.w));
                *(u32x4*)(dd + (size_t)(t0 + i0 + i) * D + 8 * c) = o;
            }
        }
    }
}

__device__ __forceinline__ void fixup_phase(const float* side, const float* cw, const float* cb, bf16_t* Aout, int gtid, int NT) {
    for (int idx = gtid; idx < 128 * 2 * (FF / 4); idx += NT) {
        const int c = 4 * (idx % (FF / 4)), i = (idx / (FF / 4)) & 1, pm = idx / (2 * (FF / 4));
        const int sc = (c >> 7) * 256 + (c & 127);
        const f32x4 z = (f32x4){0.f, 0.f, 0.f, 0.f};
        const bool first = (pm & 15) == 0;
        const float* sp = side + (size_t)pm * 4 * FF2 + sc; const float* pp = sp - 4 * FF2;
        f32x4 o;
        {
            const f32x4 gm2 = first ? z : *(const f32x4*)(pp + 2 * FF2), gm1 = first ? z : *(const f32x4*)(pp + 3 * FF2), g0 = *(const f32x4*)(sp), g1 = *(const f32x4*)(sp + FF2);
            const f32x4 vm2 = first ? z : *(const f32x4*)(pp + 2 * FF2 + 128), vm1 = first ? z : *(const f32x4*)(pp + 3 * FF2 + 128), v0 = *(const f32x4*)(sp + 128), v1 = *(const f32x4*)(sp + FF2 + 128);
            const f32x4 wg0 = *(const f32x4*)(cw + c), wg1 = *(const f32x4*)(cw + FF2 + c), wg2 = *(const f32x4*)(cw + 2 * FF2 + c), bg = *(const f32x4*)(cb + c);
            const f32x4 wv0 = *(const f32x4*)(cw + FF + c), wv1 = *(const f32x4*)(cw + FF2 + FF + c), wv2 = *(const f32x4*)(cw + 2 * FF2 + FF + c), bv = *(const f32x4*)(cb + FF + c);
            const f32x4 cgv = (i == 0) ? (wg2 * g0 + wg1 * gm1 + wg0 * gm2 + bg) : (wg2 * g1 + wg1 * g0 + wg0 * gm1 + bg);
            const f32x4 cvv = (i == 0) ? (wv2 * v0 + wv1 * vm1 + wv0 * vm2 + bv) : (wv2 * v1 + wv1 * v0 + wv0 * vm1 + bv);
#pragma unroll
            for (int e = 0; e < 4; ++e) o[e] = gelu_tanh(cgv[e]) * cvv[e];
        }
        u32x2 w; w.x = pk2(o[0], o[1]); w.y = pk2(o[2], o[3]);
        *(u32x2*)(Aout + (size_t)(pm * 256 + i) * FF + c) = w;
    }
}

constexpr int AT_KROW = 144, AT_VROW = 528, AT_VOFF = 256 * AT_KROW;
__device__ __forceinline__ void attn_phase(LAS unsigned char* lds, const bf16_t* Q, const bf16_t* Kb, const bf16_t* Vt, bf16_t* O, const float* sinks, int blk, int G, int wave, int lane, int tid) {
    const int q = lane & 31, hi = lane >> 5;
    const int NU = BATCH * NKVH * 32, UPB = (NU + G - 1) / G;
    u32x4 kr[4], vr[4];
#define AT_LOAD(u_) do { const int b_ = (u_) >> 7, hk_ = ((u_) >> 5) & 3, nb_ = (u_) & 31; \
        int kp_ = nb_ * 128 - 128 + (tid >> 1); if (kp_ < 0) kp_ += 128; \
        int vp_ = nb_ * 128 - 128 + (tid & 7) * 32; if (vp_ < 0) vp_ += 128; \
        const bf16_t* ks_ = Kb + (size_t)(b_ * SEQ + kp_) * 256 + hk_ * 64 + (tid & 1) * 32; \
        const bf16_t* vs_ = Vt + ((size_t)((b_ * NKVH + hk_) * HD + (tid >> 3))) * SEQ + vp_; \
        _Pragma("unroll") for (int j_ = 0; j_ < 4; ++j_) { kr[j_] = *(const u32x4*)(ks_ + j_ * 8); vr[j_] = *(const u32x4*)(vs_ + j_ * 8); } } while (0)
    for (int i = 0; i < UPB; ++i) {
        const int u = blk * UPB + i; if (u >= NU) break;
        const int b = u >> 7, hk = (u >> 5) & 3, nb = u & 31;
        if (i == 0) AT_LOAD(u);
        __syncthreads();
#pragma unroll
        for (int j = 0; j < 4; ++j) { *(LAS u32x4*)(lds + (tid >> 1) * AT_KROW + (tid & 1) * 64 + j * 16) = kr[j]; *(LAS u32x4*)(lds + AT_VOFF + (tid >> 3) * AT_VROW + (tid & 7) * 64 + j * 16) = vr[j]; }
        __syncthreads();
        if (i + 1 < UPB && u + 1 < NU) AT_LOAD(u + 1);
        const int gq = wave >> 1, hq = hk * 4 + gq;
        const float sink2 = sinks[hq] * LOG2E;
#pragma unroll 1
        for (int t = 0; t < 2; ++t) {
            const int sb = 2 * (wave & 1) + t;
            const int row0 = b * SEQ + nb * 128 + sb * 32;
            bf16x8 qf[4];
            { const bf16_t* qp = Q + (size_t)(row0 + q) * D + hq * 64 + hi * 8;
#pragma unroll
              for (int s = 0; s < 4; ++s) qf[s] = *(const bf16x8*)(qp + s * 16); }
            f32x16 st[5];
            const LAS unsigned char* kl = lds + (32 * sb + q) * AT_KROW + hi * 16;
#pragma unroll
            for (int kbi = 0; kbi < 5; ++kbi) {
                f32x16 a = {};
#pragma unroll
                for (int s = 0; s < 4; ++s) { const bf16x8 kf = *(const LAS bf16x8*)(kl + kbi * 32 * AT_KROW + s * 32); a = __builtin_amdgcn_mfma_f32_32x32x16_bf16(kf, qf[s], a, 0, 0, 0); }
                st[kbi] = a;
            }
            const float NEG = -1e30f;
#pragma unroll
            for (int kbi = 0; kbi < 5; ++kbi) {
                const bool dead = (nb == 0) && (sb + kbi < 4);
#pragma unroll
                for (int r = 0; r < 16; ++r) {
                    const int kk = (r & 3) + 8 * (r >> 2) + 4 * hi;
                    bool ok = !dead;
                    if (kbi == 0) ok = ok && (kk > q);
                    if (kbi == 4) ok = ok && (kk <= q);
                    st[kbi][r] = ok ? st[kbi][r] : NEG;
                }
            }
            float mx = sink2;
#pragma unroll
            for (int kbi = 0; kbi < 5; ++kbi)
#pragma unroll
                for (int r = 0; r < 16; ++r) mx = fmaxf(mx, st[kbi][r]);
            mx = fmaxf(mx, __shfl_xor(mx, 32));
            float sum = 0.f;
            bf16x8 pw[5][2];
#pragma unroll
            for (int kbi = 0; kbi < 5; ++kbi) {
                float p[16];
#pragma unroll
                for (int r = 0; r < 16; ++r) { p[r] = __builtin_amdgcn_exp2f(st[kbi][r] - mx); sum += p[r]; }
#pragma unroll
                for (int h = 0; h < 2; ++h) { u32x4 w; w.x = pk2(p[8 * h + 0], p[8 * h + 1]); w.y = pk2(p[8 * h + 2], p[8 * h + 3]); w.z = pk2(p[8 * h + 4], p[8 * h + 5]); w.w = pk2(p[8 * h + 6], p[8 * h + 7]);
                    pw[kbi][h] = __builtin_bit_cast(bf16x8, w); }
            }
            sum += __shfl_xor(sum, 32);
            const float inv = 1.0f / (sum + __builtin_amdgcn_exp2f(sink2 - mx));
            f32x16 ot[2]; ot[0] = f32x16{}; ot[1] = f32x16{};
            const LAS unsigned char* vl = lds + AT_VOFF + q * AT_VROW + (32 * sb + hi * 8) * 2;
#pragma unroll
            for (int kbi = 0; kbi < 5; ++kbi)
#pragma unroll
                for (int h = 0; h < 2; ++h)
#pragma unroll
                    for (int dh = 0; dh < 2; ++dh) {
                        const bf16x8 vf = *(const LAS bf16x8*)(vl + dh * 32 * AT_VROW + (kbi * 32 + h * 16) * 2);
                        ot[dh] = __builtin_amdgcn_mfma_f32_32x32x16_bf16(vf, pw[kbi][h], ot[dh], 0, 0, 0);
                    }
            bf16_t* op = O + (size_t)(row0 + q) * D + hq * 64 + 4 * hi;
#pragma unroll
            for (int dh = 0; dh < 2; ++dh)
#pragma unroll
                for (int rg = 0; rg < 4; ++rg) { u32x2 w; w.x = pk2(ot[dh][4 * rg + 0] * inv, ot[dh][4 * rg + 1] * inv); w.y = pk2(ot[dh][4 * rg + 2] * inv, ot[dh][4 * rg + 3] * inv);
                    *(u32x2*)(op + dh * 32 + 8 * rg) = w; }
        }
    }
#undef AT_LOAD
    __syncthreads();
}

#define XB_TMO      128
#define XB_XCNT(j)  (256  + 64 * (j))
#define XB_XSUB(j)  (1280 + 64 * (j))
#define XB_XGEN(j)  (2304 + 64 * (j))
#define XB_TOP      3328
#define XB_TOPGEN   3392
#define XCD_BAR_WORDS 3456
#define XB_SPIN_CAP (1u << 18)

__device__ __forceinline__ unsigned xb_ld(unsigned* p)              { return __hip_atomic_load(p, __ATOMIC_RELAXED, __HIP_MEMORY_SCOPE_AGENT); }
__device__ __forceinline__ unsigned xb_add(unsigned* p, unsigned v) { return __hip_atomic_fetch_add(p, v, __ATOMIC_RELAXED, __HIP_MEMORY_SCOPE_AGENT); }
__device__ __forceinline__ unsigned xb_xcc_id() { return (unsigned)__builtin_amdgcn_s_getreg((3 << 11) | 20) & 0xFu; }
#define XB_SPIN(cond, bar) do { unsigned _sp = 0; while (cond) { __builtin_amdgcn_s_sleep(1); \
    if ((++_sp & 255u) == 0u) { if (xb_ld(&(bar)[XB_TMO])) break; if (_sp > XB_SPIN_CAP) { atomicAdd(&(bar)[XB_TMO], 1u); break; } } } } while (0)

struct XcdBarrier {
    unsigned* bar; unsigned x;
    volatile LAS unsigned* st;
};

__device__ __forceinline__ XcdBarrier xcd_barrier_post(unsigned* bar, volatile LAS unsigned* st) {
    XcdBarrier b; b.bar = bar; b.x = xb_xcc_id(); b.st = st;
    if (threadIdx.x == 0) (void)xb_add(&bar[XB_XCNT(b.x)], 1u);
    return b;
}
__device__ __forceinline__ void xcd_barrier_complete(unsigned* bar, unsigned x, unsigned& nloc, unsigned& nx) {
    const unsigned G = gridDim.x * gridDim.y * gridDim.z;
    unsigned sum, cnt, mine, sp = 0u;
    for (;;) {
        sum = 0u; cnt = 0u; mine = 0u;
#pragma unroll
        for (unsigned j = 0; j < 16; ++j) { const unsigned c = xb_ld(&bar[XB_XCNT(j)]); sum += c; cnt += (c > 0u) ? 1u : 0u; mine = (j == x) ? c : mine; }
        if (sum == G) break;
        __builtin_amdgcn_s_sleep(1);
        if ((++sp & 255u) == 0u) { if (xb_ld(&bar[XB_TMO])) break; if (sp > XB_SPIN_CAP) { atomicAdd(&bar[XB_TMO], 1u); break; } }
    }
    nloc = mine > 0u ? mine : 1u; nx = cnt > 0u ? cnt : 1u;
}

__device__ __forceinline__ void xcd_barrier(const XcdBarrier& b) {
    asm volatile("s_waitcnt vmcnt(0)" ::: "memory");
    __syncthreads();
    if (threadIdx.x == 0) {
        unsigned* bar = b.bar;
        __builtin_amdgcn_s_waitcnt(0);
        unsigned nloc = b.st[0], nx = b.st[1];
        if (nloc == 0u) { xcd_barrier_complete(bar, b.x, nloc, nx); b.st[0] = nloc; b.st[1] = nx; }
        const unsigned old = xb_add(&bar[XB_XSUB(b.x)], 1u);
        const unsigned gen = old / nloc;
        if (old + 1u == (gen + 1u) * nloc) {
            __builtin_amdgcn_fence(__ATOMIC_RELEASE, "agent");
            asm volatile("s_waitcnt vmcnt(0)" ::: "memory");
            const unsigned og = xb_add(&bar[XB_TOP], 1u);
            const unsigned tg = og / nx;
            if (og + 1u == (tg + 1u) * nx) xb_add(&bar[XB_TOPGEN], 1u);
            else XB_SPIN(xb_ld(&bar[XB_TOPGEN]) == tg, bar);
            __builtin_amdgcn_fence(__ATOMIC_ACQUIRE, "agent");
            xb_add(&bar[XB_XGEN(b.x)], 1u);
            asm volatile("s_waitcnt vmcnt(0)" ::: "memory");
        } else {
            XB_SPIN(xb_ld(&bar[XB_XGEN(b.x)]) == gen, bar);
            __builtin_amdgcn_fence(__ATOMIC_ACQUIRE, "agent");
            asm volatile("s_waitcnt vmcnt(0)" ::: "memory");
        }
    }
    __syncthreads();
}

enum { T_PRO = 0, T_ROWA, T_DIFF, T_POOLG, T_ROWB, T_QKV, T_ATTN, T_WO, T_GLU, T_FIX, T_DOWN };
constexpr int NPH = 31;
#ifndef PH_MASK
#define PH_MASK 0xFFFF
#endif
#define PH_ON(t) (((PH_MASK) >> (t)) & 1)
__host__ __device__ __forceinline__ void decode_phase(int ph, int& type, int& layer) {
    if (ph == 0) { type = T_PRO; layer = 0; return; }
    if (ph <= 6) { type = (int)((0xA98432ull >> (4 * (ph - 1))) & 15); layer = 0; return; }
    if (ph <= 13) { type = (int)((0xA984321ull >> (4 * (ph - 7))) & 15); layer = 1; return; }
    if (ph <= 29) { type = (int)((0xA9847651ull >> (4 * ((ph - 14) & 7))) & 15); layer = 2 + ((ph - 14) >> 3); return; }
    type = T_ROWA; layer = 4;
}

template <bool COOP>
__global__ void __launch_bounds__(NWAVES * 64, 2) yoco_fwd(Args a) {
    extern __shared__ __attribute__((aligned(16))) unsigned char lds_raw[];
    LAS unsigned char* lds = (LAS unsigned char*)lds_raw;
    const int G = gridDim.x, blk = blockIdx.x;
    const int wave_s = __builtin_amdgcn_readfirstlane(threadIdx.x >> 6);
    volatile LAS unsigned* MISC = (volatile LAS unsigned*)(lds + pg8::STAGE_BYTES + 8192);
    if (threadIdx.x < 16) MISC[threadIdx.x] = 0u;
    __syncthreads();
    XcdBarrier xbar; xbar.bar = (unsigned*)(a.ws + WS_CTL); xbar.x = 0; xbar.st = nullptr;
    if constexpr (COOP) xbar = xcd_barrier_post((unsigned*)(a.ws + WS_CTL), MISC + 8);
    int ph0 = a.ph_lo;
    if (PH_ON(T_PRO) && ph0 == 0) {
        int lane = __builtin_amdgcn_mbcnt_hi(~0u, __builtin_amdgcn_mbcnt_lo(~0u, 0u)); asm volatile("" : "+v"(lane));
        const int wave = wave_s, tid = wave * 64 + lane;
        const int gw = blk * NWAVES + wave, NGW = G * NWAVES;
        unsigned char* ws = a.ws; asm volatile("" : "+s"(ws));
        bf16_t* BT1 = (bf16_t*)(ws + WS_BT1); bf16_t* BT2 = (bf16_t*)(ws + WS_BT2); bf16_t* BTQKV = (bf16_t*)(ws + WS_BTQKV); bf16_t* BTO = (bf16_t*)(ws + WS_BTO); bf16_t* BTP = (bf16_t*)(ws + WS_BTP);
        float* COSB = (float*)(ws + WS_COS); float* SINB = (float*)(ws + WS_SIN); bf16_t* XN = (bf16_t*)(ws + WS_XN);
        {
            LAS float* scr = (LAS float*)(lds + wave * 16384);
            constexpr int I_IN = 16 * 176, I_OUT = 44 * 32, I_Q = 16 * 32, I_KV = 16 * 16, I_O = 16 * 32, I_P = 4 * 8;
            constexpr int NITEMS = 4 * I_IN + 4 * I_OUT + 2 * I_Q + I_KV + 2 * I_O + 8 * I_P;
            for (int it = gw; it < NITEMS; it += NGW) {
                int r = it;
                if (r < 4 * I_IN) { const int l = r / I_IN; r %= I_IN; const int kb = r / 176, nbk = r % 176, n0 = nbk * 32;
                    const int bj = n0 / FF, rem = n0 % FF, pn = rem / 128, j = rem % 128;
                    transpose_item(a.ffn_w_in + (size_t)l * D * FF2, FF2, kb * 64, n0, BT1 + (size_t)l * FF2 * D, D, pn * 256 + bj * 128 + j, a.ffn_pre_g + l * D, nullptr, 1.0f, scr, lane); continue; }
                r -= 4 * I_IN;
                if (r < 4 * I_OUT) { const int l = r / I_OUT; r %= I_OUT; const int kb = r / 32, nbk = r % 32;
                    transpose_item(a.ffn_w_out + (size_t)l * FF * D, D, kb * 64, nbk * 32, BT2 + (size_t)l * D * FF, FF, nbk * 32, nullptr, nullptr, 1.0f, scr, lane); continue; }
                r -= 4 * I_OUT;
                if (r < 2 * I_Q) { const int j2 = r / I_Q; r %= I_Q; const int kb = r / 32, nbk = r % 32, n0 = nbk * 32;
                    const int head = n0 >> 6, half = (n0 >> 5) & 1;
                    transpose_item(a.w_q + (size_t)j2 * D * D, D, kb * 64, n0, BTQKV + (size_t)j2 * NQKV * D, D, (head >> 2) * 256 + half * 128 + (head & 3) * 32, a.mix_pre_g + (2 + j2) * D, nullptr, 0.125f * LOG2E, scr, lane); continue; }
                r -= 2 * I_Q;
                if (r < I_KV) { const int kb = r / 16, nbk = r % 16, n0 = nbk * 32;
                    int orow; if (n0 < 256) { const int head = n0 >> 6, half = (n0 >> 5) & 1; orow = 1024 + half * 128 + head * 32; } else orow = 1280 + (n0 - 256);
                    transpose_item(a.w_kv, 512, kb * 64, n0, BTQKV, D, orow, a.kv_norm_g, nullptr, 1.0f, scr, lane); continue; }
                r -= I_KV;
                if (r < 2 * I_O) { const int j2 = r / I_O; r %= I_O; const int kb = r / 32, nbk = r % 32;
                    transpose_item(a.w_o + (size_t)j2 * D * D, D, kb * 64, nbk * 32, BTO + (size_t)j2 * D * D, D, nbk * 32, nullptr, nullptr, 1.0f, scr, lane); continue; }
                r -= 2 * I_O;
                { const int lg = r / I_P; r %= I_P; const int l = lg >> 2, grp = lg & 3, kb = r / 8, nbk = r % 8;
                    transpose_item(a.pool_w + (size_t)lg * 256 * 256, 256, kb * 64, nbk * 32, BTP + (size_t)l * D * 256, 256, grp * 256 + nbk * 32, a.mix_pre_g + l * D + grp * 256, a.pool_scale + l * D + grp * 256, 1.0f, scr, lane); }
            }
            for (int idx = blk * (NWAVES * 64) + tid; idx < M * 32; idx += G * NWAVES * 64) {
                const int row = idx >> 5, i = idx & 31;
                const float ang = (float)a.positions[row] * a.inv_freq[i];
                const double ad = (double)ang; const double kq = rint(ad * 0.63661977236758134308); const double rr = ad - kq * 1.57079632679489661923;
                const double r2 = rr * rr;
                const double sv = rr * (1.0 + r2 * (-1.0 / 6 + r2 * (1.0 / 120 + r2 * (-1.0 / 5040 + r2 * (1.0 / 362880 + r2 * (-1.0 / 39916800 + r2 * (1.0 / 6227020800.0)))))));
                const double cv = 1.0 + r2 * (-0.5 + r2 * (1.0 / 24 + r2 * (-1.0 / 720 + r2 * (1.0 / 40320 + r2 * (-1.0 / 3628800 + r2 * (1.0 / 479001600.0 + r2 * (-1.0 / 87178291200.0)))))));
                const int qd = ((int)kq) & 3;
                const double c = (qd == 0) ? cv : (qd == 1) ? -sv : (qd == 2) ? -cv : sv;
                const double s = (qd == 0) ? sv : (qd == 1) ? cv : (qd == 2) ? -sv : -cv;
                COSB[idx] = (float)c; SINB[idx] = (float)s;
            }
            row_phase(a.x, nullptr, nullptr, nullptr, XN, gw, NGW, lane);
        }
        ph0 = 1;
        if (ph0 < a.ph_hi) { if constexpr (COOP) { cg::this_grid().sync(); } }
    }
    int rep = 0; (void)rep;
    for (int ph = ph0 < 1 ? 1 : ph0; ph < a.ph_hi; ++ph) {
        int type, layer; decode_phase(ph, type, layer);
        int lane = __builtin_amdgcn_mbcnt_hi(~0u, __builtin_amdgcn_mbcnt_lo(~0u, 0u)); asm volatile("" : "+v"(lane));
        const int wave = wave_s, tid = wave * 64 + lane;
        const int gw = blk * NWAVES + wave, NGW = G * NWAVES;
        unsigned char* ws = a.ws; asm volatile("" : "+s"(ws));
        bf16_t* BT1 = (bf16_t*)(ws + WS_BT1); bf16_t* BT2 = (bf16_t*)(ws + WS_BT2); bf16_t* BTQKV = (bf16_t*)(ws + WS_BTQKV); bf16_t* BTO = (bf16_t*)(ws + WS_BTO); bf16_t* BTP = (bf16_t*)(ws + WS_BTP);
        float* COSB = (float*)(ws + WS_COS); float* SINB = (float*)(ws + WS_SIN); float* SIDE = (float*)(ws + WS_SIDE);
        bf16_t* XN = (bf16_t*)(ws + WS_XN); bf16_t* TB = (bf16_t*)(ws + WS_T); bf16_t* KB = (bf16_t*)(ws + WS_K); bf16_t* VT = (bf16_t*)(ws + WS_VT);
        bf16_t* AB = (bf16_t*)(ws + WS_A); bf16_t* DB = AB; bf16_t* QO = AB; bf16_t* OB = AB + (size_t)M * D;
        if (false) {
        } else if (PH_ON(T_ROWA) && type == T_ROWA) {
            row_phase(a.out, TB, a.ffn_post_g + (layer - 1) * D, a.out, layer < DEPTH ? XN : nullptr, gw, NGW, lane);
        } else if (PH_ON(T_ROWB) && type == T_ROWB) {
            row_phase(layer == 0 ? a.x : a.out, TB, a.mix_post_g + layer * D, a.out, XN, gw, NGW, lane);
        } else if (PH_ON(T_DIFF) && type == T_DIFF) {
            diff_phase(XN, DB, blk * (NWAVES * 64) + tid, G * NWAVES * 64);
        } else if (PH_ON(T_FIX) && type == T_FIX) {
            fixup_phase(SIDE, a.ffn_conv_w + (size_t)layer * 3 * FF2, a.ffn_conv_b + (size_t)layer * FF2, AB, blk * (NWAVES * 64) + tid, G * NWAVES * 64);
        } else if (PH_ON(T_ATTN) && type == T_ATTN) {
            attn_phase(lds, QO, KB, VT, OB, a.sinks + (layer - 2) * NQH, blk, G, wave, lane, tid);
        } else if (PH_ON(T_GLU) && type == T_GLU) {
            pg8::Gemm g{XN, BT1 + (size_t)layer * FF2 * D, D, D, D, 0}; pg8::StaticOrder S; S.init(M, FF2, G, blk);
            pg8::EpiGlu E{AB, a.ffn_conv_w + (size_t)layer * 3 * FF2, a.ffn_conv_b + (size_t)layer * FF2, SIDE};
            pg8::gemm_phase<pg8::EpiGlu, pg8::StaticOrder, true, true>(lds, g, S, E, tid);
        } else if (PH_ON(T_QKV) && type == T_QKV) {
            pg8::Gemm g{XN, BTQKV + (size_t)(layer - 2) * NQKV * D, D, D, D, 0}; pg8::StaticOrder S; S.init(M, layer == 2 ? NQKV : D, G, blk);
            pg8::EpiQKV E{QO, KB, VT, COSB, SINB};
            pg8::gemm_phase<pg8::EpiQKV, pg8::StaticOrder, true, true>(lds, g, S, E, tid);
        } else if (PH_ON(T_DOWN)) {
            pg8::Gemm g;
            if (type == T_POOLG) g = pg8::Gemm{DB, BTP + (size_t)layer * D * 256, D, 256, 256, 256};
            else if (type == T_WO) g = pg8::Gemm{OB, BTO + (size_t)(layer - 2) * D * D, D, D, D, 0};
            else g = pg8::Gemm{AB, BT2 + (size_t)layer * D * FF, FF, FF, FF, 0};
            pg8::StaticOrder S; S.init(M, D, G, blk);
            pg8::EpiBf16 E{TB, D};
            pg8::gemm_phase<pg8::EpiBf16, pg8::StaticOrder, true, true>(lds, g, S, E, tid);
        }
        if (ph + 1 < a.ph_hi) {
            if constexpr (COOP) { xcd_barrier(xbar); }
        }
#if defined(PROBE_DUP)
        if ((((PROBE_DUP) >> type) & 1) && rep == 0) { rep = 1; --ph; } else rep = 0;
#endif
    }
}

extern "C" void kernel_launch(void* const* d_in, const int* in_sizes, int n_in, void* d_out, int out_size, void* d_ws, size_t ws_size, hipStream_t stream) {
    static int grid = 0;
    static float invf[32];
    if (grid == 0) {
        if (n_in != 17 || out_size != M * D || ws_size < WS_END) { fprintf(stderr, "kernel_launch: unexpected shapes (n_in %d, out %d, ws %zu)\n", n_in, out_size, ws_size); grid = -1; return; }
        int dev = 0, cus = 0, per_cu = 0;
        (void)hipGetDevice(&dev); (void)hipDeviceGetAttribute(&cus, hipDeviceAttributeMultiprocessorCount, dev);
#if defined(MK_PER_PHASE)
        const void* kfn = (const void*)yoco_fwd<false>;
#else
        const void* kfn = (const void*)yoco_fwd<true>;
#endif
        (void)hipFuncSetAttribute(kfn, hipFuncAttributeMaxDynamicSharedMemorySize, LDS_BYTES);
        (void)hipOccupancyMaxActiveBlocksPerMultiprocessor(&per_cu, kfn, NWAVES * 64, LDS_BYTES);
        if (per_cu < 1) { fprintf(stderr, "kernel_launch: occupancy query says %d blocks per CU\n", per_cu); per_cu = 1; }
        (void)hipGetLastError();
        grid = cus * per_cu;
        for (int i = 0; i < 32; ++i) invf[i] = 1.0f / powf(10000.0f, (float)(2 * i) / 64.0f);
    }
    if (grid < 0) return;
    Args a{};
    a.x = (const float*)d_in[0]; a.positions = (const int*)d_in[1]; a.mix_pre_g = (const float*)d_in[2]; a.mix_post_g = (const float*)d_in[3]; a.pool_w = (const float*)d_in[4];
    a.pool_scale = (const float*)d_in[5]; a.kv_norm_g = (const float*)d_in[6]; a.w_kv = (const float*)d_in[7]; a.w_q = (const float*)d_in[8]; a.w_o = (const float*)d_in[9];
    a.sinks = (const float*)d_in[10]; a.ffn_pre_g = (const float*)d_in[11]; a.ffn_post_g = (const float*)d_in[12]; a.ffn_w_in = (const float*)d_in[13]; a.ffn_conv_w = (const float*)d_in[14];
    a.ffn_conv_b = (const float*)d_in[15]; a.ffn_w_out = (const float*)d_in[16];
    a.out = (float*)d_out; a.ws = (unsigned char*)d_ws;
    for (int i = 0; i < 32; ++i) a.inv_freq[i] = invf[i];
#if defined(MK_PER_PHASE)
    for (int ph = 0; ph < NPH; ++ph) { a.ph_lo = ph; a.ph_hi = ph + 1; hipLaunchKernelGGL(yoco_fwd<false>, dim3(grid), dim3(NWAVES * 64), LDS_BYTES, stream, a); }
#else
    a.ph_lo = 0; a.ph_hi = NPH;
    (void)hipMemsetAsync((char*)d_ws + WS_CTL, 0, CTL_BYTES, stream);
    void* args[] = {&a};
    hipError_t e = hipLaunchCooperativeKernel((const void*)yoco_fwd<true>, dim3(grid), dim3(NWAVES * 64), args, LDS_BYTES, stream);
    if (e != hipSuccess) fprintf(stderr, "cooperative launch failed: %s (grid %d)\n", hipGetErrorString(e), grid);
#endif
}
```

```cpp
#include <hip/hip_runtime.h>
#include <hip/hip_cooperative_groups.h>
#include <cstdio>
#include <cstdint>
#include <cmath>
namespace cg = cooperative_groups;

#define LAS __attribute__((address_space(3)))
#define PG8_LAS LAS
typedef unsigned short bf16_t;
typedef short bf16x8 __attribute__((ext_vector_type(8)));
typedef float f32x4 __attribute__((ext_vector_type(4)));
typedef float f32x16 __attribute__((ext_vector_type(16)));
typedef unsigned u32x4 __attribute__((ext_vector_type(4)));
typedef unsigned u32x2 __attribute__((ext_vector_type(2)));
typedef float f32x2_t __attribute__((ext_vector_type(2)));
typedef __bf16 bf16x2_t __attribute__((ext_vector_type(2)));

constexpr int D = 1024, BATCH = 8, SEQ = 4096, M = BATCH * SEQ, DEPTH = 4, NA = 2, FF = 2816, FF2 = 5632;
constexpr int HD = 64, NQH = 16, NKVH = 4, NQKV = 1536;
constexpr float RMS_EPS = 1e-6f;
constexpr float LOG2E = 1.4426950408889634f;

__device__ __forceinline__ unsigned pk2(float lo, float hi) { f32x2_t v = {lo, hi}; bf16x2_t b = __builtin_convertvector(v, bf16x2_t); return __builtin_bit_cast(unsigned, b); }
typedef _Float16 h16x2 __attribute__((ext_vector_type(2)));
__device__ __forceinline__ unsigned pkh2(float lo, float hi) { h16x2 h = {(_Float16)lo, (_Float16)hi}; return __builtin_bit_cast(unsigned, h); }
__device__ __forceinline__ float h_lo(unsigned u) { return (float)__builtin_bit_cast(h16x2, u).x; }
__device__ __forceinline__ float h_hi(unsigned u) { return (float)__builtin_bit_cast(h16x2, u).y; }
__device__ __forceinline__ float bf_lo(unsigned u) { return __builtin_bit_cast(float, u << 16); }
__device__ __forceinline__ float bf_hi(unsigned u) { return __builtin_bit_cast(float, u & 0xffff0000u); }
template <int CTRL> __device__ __forceinline__ float dppf(float old, float src) {
    return __builtin_bit_cast(float, __builtin_amdgcn_update_dpp(__builtin_bit_cast(int, old), __builtin_bit_cast(int, src), CTRL, 0xf, 0xf, false));
}
constexpr int DPP_SHR1 = 0x111, DPP_SHR2 = 0x112, DPP_ROR1 = 0x121, DPP_ROR2 = 0x122;
__device__ __forceinline__ float gelu_tanh(float x) {
    const float c1 = -2.0f * 0.7978845608028654f * LOG2E, c2 = c1 * 0.044715f;
    const float t = x * (c1 + c2 * x * x);
    const float e = __builtin_amdgcn_exp2f(t);
    return x * __builtin_amdgcn_rcpf(1.0f + e);
}

namespace pg8 {
constexpr int BM = 256, BK = 64, HALF = 128, HTB = HALF * BK * 2  , STAGE_BYTES = 8 * HTB, NXCD = 8, WGM = 8;
__host__ __device__ __forceinline__ int lds_byte(int r, int c) { const int st = (r >> 4) * 2 + (c >> 5), rr = r & 15, cc = c & 31, ob = rr * 64 + cc * 2; return st * 1024 + (ob ^ (((ob >> 9) & 1) << 5)); }
__host__ __device__ __forceinline__ void stage_rc(int b, int& R, int& C) { const int st = b / 1024, sb = b % 1024, swz = sb ^ (((sb >> 9) & 1) << 5); R = (st >> 1) * 16 + swz / 64; C = (st & 1) * 32 + (swz % 64) / 2; }
__host__ __device__ __forceinline__ int perm32(int rho) { const int n = rho >> 4, i = rho & 15; return 8 * (i >> 2) + 4 * n + (i & 3); }

struct Unit { int pm, pn; };
struct Gemm { const bf16_t* A; const bf16_t* Bt; int lda, ldb, K, acol; };

struct StaticOrder {
    int nM, nN, nwg, G, c;
    __host__ __device__ void init(int M_, int N_, int G_, int c_) { nM = M_ / BM; nN = N_ / BM; nwg = nM * nN; G = G_; c = c_; }
    __host__ __device__ bool next(int i, Unit& u) const {
        const long L = (long)i * G + c; if (L >= nwg) return false;
        int wgid = (int)L; { const int q = nwg / NXCD, r = nwg % NXCD, xcd = wgid % NXCD, off = wgid / NXCD; wgid = (xcd < r ? xcd * (q + 1) : r * (q + 1) + (xcd - r) * q) + off; }
        const int nig = WGM * nN, gid = wgid / nig, fm = gid * WGM, gsz = (nM - fm) < WGM ? (nM - fm) : WGM;
        u.pm = fm + ((wgid % nig) % gsz); u.pn = (wgid % nig) / gsz; return true;
    }
    __device__ __forceinline__ void a_ready(const Unit&) const {}
    __device__ __forceinline__ void done(const Unit&) const {}
};

struct RowStats {
    float* xbuf; unsigned* cnt;
    __device__ __forceinline__ void run(const f32x4 (&v)[2][2][4][2], const Unit& u, int wr, int wc, int fr, int fq, LAS unsigned char* xl, int wid, int lane) const {
        LAS float* P = (LAS float*)xl;
        LAS float* S = (LAS float*)(xl + 4096);
#pragma unroll
        for (int ai = 0; ai < 2; ++ai)
#pragma unroll
            for (int m = 0; m < 4; ++m) {
                float q = 0.f;
#pragma unroll
                for (int bj = 0; bj < 2; ++bj)
#pragma unroll
                    for (int n = 0; n < 2; ++n) { const f32x4 d = v[ai][bj][m][n]; q += (d[0] * d[0] + d[1] * d[1]) + (d[2] * d[2] + d[3] * d[3]); }
                q += __shfl_xor(q, 16); q += __shfl_xor(q, 32);
                if (fq == 0) P[(ai * HALF + wr * 64 + m * 16 + fr) * 4 + wc] = q;
            }
        asm volatile("s_waitcnt lgkmcnt(0)" ::: "memory"); __builtin_amdgcn_s_barrier(); asm volatile("" ::: "memory");
        const int row = wid * 32 + (lane & 31);
        if (lane < 32) {
            const float tot = (P[row * 4 + 0] + P[row * 4 + 1]) + (P[row * 4 + 2] + P[row * 4 + 3]);
            __hip_atomic_store(xbuf + ((size_t)(u.pm * BM + row) * 4 + u.pn), tot, __ATOMIC_RELAXED, __HIP_MEMORY_SCOPE_AGENT);
        }
        asm volatile("s_waitcnt vmcnt(0)" ::: "memory");
        if (lane == 0) __hip_atomic_fetch_add(cnt + 64 * u.pm, 1u, __ATOMIC_RELAXED, __HIP_MEMORY_SCOPE_AGENT);
        if (wid == 0) {
            unsigned sp = 0;
            for (;;) {
                if ((unsigned)__builtin_amdgcn_readfirstlane(__hip_atomic_load(cnt + 64 * u.pm, __ATOMIC_RELAXED, __HIP_MEMORY_SCOPE_AGENT)) >= 32u) break;
                if (++sp > (1u << 22)) break;
                __builtin_amdgcn_s_sleep(1);
            }
            __builtin_amdgcn_fence(__ATOMIC_ACQUIRE, "agent");
        }
        asm volatile("s_waitcnt vmcnt(0) lgkmcnt(0)" ::: "memory"); __builtin_amdgcn_s_barrier(); asm volatile("" ::: "memory");
        if (lane < 32) {
            const float* slot = xbuf + (size_t)(u.pm * BM + row) * 4; float q = 0.f;
#pragma unroll
            for (int t = 0; t < 4; ++t) q += __hip_atomic_load(slot + t, __ATOMIC_RELAXED, __HIP_MEMORY_SCOPE_AGENT);
            S[row] = 1.0f / sqrtf(q * (1.0f / 1024.0f) + RMS_EPS);
        }
        asm volatile("s_waitcnt lgkmcnt(0)" ::: "memory"); __builtin_amdgcn_s_barrier(); asm volatile("" ::: "memory");
    }
};
struct EpiResNorm {
    static constexpr bool PERM = false, AFTER_DRAIN = false, APERM = false;
    const void* xsrc; void* xdst; int src16, dst16; bf16_t* xn; const float* g; RowStats st1, st2;
    __device__ __forceinline__ void operator()(f32x4 (&acc)[2][2][4][2], const Unit& u, int wr, int wc, int fr_in, int fq_in, LAS unsigned char* xl) const {
        unsigned ones = ~0u; asm volatile("" : "+s"(ones));
        int lane = __builtin_amdgcn_mbcnt_hi(ones, __builtin_amdgcn_mbcnt_lo(ones, 0u)); asm volatile("" : "+v"(lane));
        const int fr = lane & 15, fq = lane >> 4; (void)fr_in; (void)fq_in;
        const int wid = wr * 4 + wc;
        const LAS float* S = (const LAS float*)(xl + 4096);
        const int col0 = u.pn * BM + wc * 32 + 4 * fq;
        u32x4 pre[2][2][2][2];
#define RN_LOAD(slot, ai_, mh) do { _Pragma("unroll") for (int mm = 0; mm < 2; ++mm) { const size_t off_ = (size_t)(u.pm * BM + (ai_) * HALF + wr * 64 + ((mh) * 2 + mm) * 16 + fr) * D + col0; \
            _Pragma("unroll") for (int bj = 0; bj < 2; ++bj) _Pragma("unroll") for (int n = 0; n < 2; ++n) { \
                if (src16) { const u32x2 h_ = *(const u32x2*)((const unsigned short*)xsrc + off_ + bj * HALF + n * 16); pre[slot][mm][bj][n] = (u32x4){h_.x, h_.y, 0u, 0u}; } \
                else pre[slot][mm][bj][n] = *(const u32x4*)((const float*)xsrc + off_ + bj * HALF + n * 16); } } } while (0)
#define RN_APPLY(slot, ai_, mh) do { _Pragma("unroll") for (int mm = 0; mm < 2; ++mm) { const int m_ = (mh) * 2 + mm; const int r_ = (ai_) * HALF + wr * 64 + m_ * 16 + fr; const float sr_ = S[r_]; \
            const size_t off_ = (size_t)(u.pm * BM + r_) * D + col0; \
            _Pragma("unroll") for (int bj = 0; bj < 2; ++bj) _Pragma("unroll") for (int n = 0; n < 2; ++n) { const u32x4 p_ = pre[slot][mm][bj][n]; \
                const f32x4 xs_ = src16 ? (f32x4){h_lo(p_.x), h_hi(p_.x), h_lo(p_.y), h_hi(p_.y)} : __builtin_bit_cast(f32x4, p_); \
                const f32x4 x1_ = xs_ + acc[ai_][bj][m_][n] * sr_ * *(const f32x4*)(g + col0 + bj * HALF + n * 16); acc[ai_][bj][m_][n] = x1_; \
                if (dst16) { u32x2 w_; w_.x = pkh2(x1_[0], x1_[1]); w_.y = pkh2(x1_[2], x1_[3]); *(u32x2*)((unsigned short*)xdst + off_ + bj * HALF + n * 16) = w_; } \
                else *(f32x4*)((float*)xdst + off_ + bj * HALF + n * 16) = x1_; } \
            asm volatile("" : "+v"(acc[ai_][0][m_][0]), "+v"(acc[ai_][0][m_][1]), "+v"(acc[ai_][1][m_][0]), "+v"(acc[ai_][1][m_][1])); } } while (0)
        RN_LOAD(0, 0, 0);
        st1.run(acc, u, wr, wc, fr, fq, xl, wid, lane);
        {
            RN_LOAD(1, 0, 1);
            RN_APPLY(0, 0, 0); asm volatile("" ::: "memory");
            RN_LOAD(0, 1, 0);
            RN_APPLY(1, 0, 1); asm volatile("" ::: "memory");
            RN_LOAD(1, 1, 1);
            RN_APPLY(0, 1, 0); asm volatile("" ::: "memory");
            RN_APPLY(1, 1, 1); asm volatile("" ::: "memory");
        }
#undef RN_LOAD
#undef RN_APPLY
        if (xn) {
            st2.run(acc, u, wr, wc, fr, fq, xl, wid, lane);
#pragma unroll
            for (int ai = 0; ai < 2; ++ai)
#pragma unroll
                for (int m = 0; m < 4; ++m) { const int r = ai * HALF + wr * 64 + m * 16 + fr; const float sr = S[r]; const size_t off = (size_t)(u.pm * BM + r) * D + col0;
#pragma unroll
                    for (int bj = 0; bj < 2; ++bj)
#pragma unroll
                        for (int n = 0; n < 2; ++n) { const f32x4 x1 = acc[ai][bj][m][n]; u32x2 w; w.x = pk2(x1[0] * sr, x1[1] * sr); w.y = pk2(x1[2] * sr, x1[3] * sr); *(u32x2*)(xn + off + bj * HALF + n * 16) = w; } }
        }
    }
};

struct EpiQKV {
    static constexpr bool PERM = true, AFTER_DRAIN = false, APERM = false;
    bf16_t* Q; bf16_t* Kb; bf16_t* Vt; const float* cs; const float* sn;
    __device__ __forceinline__ void operator()(f32x4 (&acc)[2][2][4][2], const Unit& u, int wr, int wc, int fr, int fq, LAS unsigned char*) const {
        if (u.pn <= 4) {
            bf16_t* base; int ld, head;
            if (u.pn < 4) { base = Q; ld = D; head = u.pn * 4 + wc; } else { base = Kb; ld = 256; head = wc; }
#pragma unroll
            for (int ai = 0; ai < 2; ++ai)
#pragma unroll
                for (int m = 0; m < 4; ++m) {
                    const int row = u.pm * BM + ai * HALF + wr * 64 + m * 16 + fr;
                    const float* cp = cs + (size_t)row * 32 + 8 * fq; const float* sp = sn + (size_t)row * 32 + 8 * fq;
                    u32x4 w1, w2;
#pragma unroll
                    for (int n = 0; n < 2; ++n) {
                        const f32x4 c = *(const f32x4*)(cp + 4 * n), s = *(const f32x4*)(sp + 4 * n);
                        const f32x4 x1 = acc[ai][0][m][n], x2 = acc[ai][1][m][n];
                        const f32x4 o1 = x1 * c - x2 * s, o2 = x2 * c + x1 * s;
                        if (n == 0) { w1.x = pk2(o1[0], o1[1]); w1.y = pk2(o1[2], o1[3]); w2.x = pk2(o2[0], o2[1]); w2.y = pk2(o2[2], o2[3]); }
                        else        { w1.z = pk2(o1[0], o1[1]); w1.w = pk2(o1[2], o1[3]); w2.z = pk2(o2[0], o2[1]); w2.w = pk2(o2[2], o2[3]); }
                    }
                    bf16_t* op = base + (size_t)row * ld + head * 64 + 8 * fq;
                    *(u32x4*)op = w1; *(u32x4*)(op + 32) = w2;
                }
        } else {
            const int pos = (fr & 3) + 4 * ((fr >> 3) & 1) + 8 * ((fr >> 2) & 1);
#pragma unroll
            for (int ai = 0; ai < 2; ++ai)
#pragma unroll
                for (int m = 0; m < 4; ++m) {
                    const int row = u.pm * BM + ai * HALF + wr * 64 + m * 16;
                    const int b = row >> 12, s = (row & 4095) + pos;
#pragma unroll
                    for (int bj = 0; bj < 2; ++bj)
#pragma unroll
                        for (int n = 0; n < 2; ++n)
#pragma unroll
                            for (int e = 0; e < 4; ++e) {
                                const int c = bj * HALF + wc * 32 + 8 * fq + 4 * n + e, hk = c >> 6, d = c & 63;
                                Vt[((size_t)((b * NKVH + hk) * HD + d)) * SEQ + s] = (bf16_t)(pk2(acc[ai][bj][m][n][e], 0.f) & 0xffffu);
                            }
                }
        }
    }
};

struct EpiGlu {
    static constexpr bool PERM = true, AFTER_DRAIN = false, APERM = true;
    bf16_t* Aout; const float* cw; const float* cb; float* side;
    __device__ __forceinline__ void operator()(f32x4 (&acc)[2][2][4][2], const Unit& u, int wr, int wc, int fr, int fq, LAS unsigned char* xl) const {
        LAS f32x4* X = (LAS f32x4*)xl;
        const int tc0 = wc * 32 + 8 * fq;
        f32x4 W[2][8];
#define GLU_LOADW(n) do { const int c0 = u.pn * 128 + tc0 + 4 * (n); \
            W[n][0] = *(const f32x4*)(cw + c0); W[n][1] = *(const f32x4*)(cw + FF2 + c0); W[n][2] = *(const f32x4*)(cw + 2 * FF2 + c0); W[n][3] = *(const f32x4*)(cb + c0); \
            W[n][4] = *(const f32x4*)(cw + FF + c0); W[n][5] = *(const f32x4*)(cw + FF2 + FF + c0); W[n][6] = *(const f32x4*)(cw + 2 * FF2 + FF + c0); W[n][7] = *(const f32x4*)(cb + FF + c0); } while (0)
        GLU_LOADW(0);
        if (fr == 15) {
#pragma unroll
            for (int ai = 0; ai < 2; ++ai)
#pragma unroll
                for (int bj = 0; bj < 2; ++bj)
#pragma unroll
                    for (int n = 0; n < 2; ++n) { X[((ai * 2 + wr) * 2 + 0) * 64 + ((bj * HALF + tc0 + 4 * n) >> 2)] = acc[ai][bj][2][n]; X[((ai * 2 + wr) * 2 + 1) * 64 + ((bj * HALF + tc0 + 4 * n) >> 2)] = acc[ai][bj][3][n]; }
        }
        if (wr == 0 && fr == 0) {
#pragma unroll
            for (int bj = 0; bj < 2; ++bj)
#pragma unroll
                for (int n = 0; n < 2; ++n) { *(f32x4*)(side + ((size_t)(u.pm * 4 + 0)) * FF2 + u.pn * 256 + bj * HALF + tc0 + 4 * n) = acc[0][bj][0][n]; *(f32x4*)(side + ((size_t)(u.pm * 4 + 1)) * FF2 + u.pn * 256 + bj * HALF + tc0 + 4 * n) = acc[0][bj][1][n]; }
        }
        if (wr == 1 && fr == 15) {
#pragma unroll
            for (int bj = 0; bj < 2; ++bj)
#pragma unroll
                for (int n = 0; n < 2; ++n) { *(f32x4*)(side + ((size_t)(u.pm * 4 + 2)) * FF2 + u.pn * 256 + bj * HALF + tc0 + 4 * n) = acc[1][bj][2][n]; *(f32x4*)(side + ((size_t)(u.pm * 4 + 3)) * FF2 + u.pn * 256 + bj * HALF + tc0 + 4 * n) = acc[1][bj][3][n]; }
        }
        asm volatile("s_waitcnt lgkmcnt(0)" ::: "memory"); __builtin_amdgcn_s_barrier(); asm volatile("" ::: "memory");
        const int row0 = u.pm * BM + wr * 64 + 4 * fr;
        const float c1 = -2.0f * 0.7978845608028654f * LOG2E, c2 = c1 * 0.044715f;
#pragma unroll
        for (int n = 0; n < 2; ++n) {
#pragma unroll
            for (int ai = 0; ai < 2; ++ai) {
                if (n == 0 && ai == 1) GLU_LOADW(1);
                const int sidx = ai * 2 + wr;
                f32x4 g2h = (f32x4){0.f, 0.f, 0.f, 0.f}, g3h = g2h, v2h = g2h, v3h = g2h;
                if (sidx > 0) { g2h = X[((sidx - 1) * 2 + 0) * 64 + ((tc0 + 4 * n) >> 2)]; g3h = X[((sidx - 1) * 2 + 1) * 64 + ((tc0 + 4 * n) >> 2)];
                                v2h = X[((sidx - 1) * 2 + 0) * 64 + ((HALF + tc0 + 4 * n) >> 2)]; v3h = X[((sidx - 1) * 2 + 1) * 64 + ((HALF + tc0 + 4 * n) >> 2)]; }
                f32x4 G2, G3, V2, V3;
#pragma unroll
                for (int e = 0; e < 4; ++e) { G2[e] = dppf<DPP_SHR1>(g2h[e], acc[ai][0][2][n][e]); G3[e] = dppf<DPP_SHR1>(g3h[e], acc[ai][0][3][n][e]);
                                              V2[e] = dppf<DPP_SHR1>(v2h[e], acc[ai][1][2][n][e]); V3[e] = dppf<DPP_SHR1>(v3h[e], acc[ai][1][3][n][e]); }
#pragma unroll
                for (int m = 0; m < 4; ++m) {
                    const f32x4 g0 = acc[ai][0][m][n], v0 = acc[ai][1][m][n];
                    const f32x4 g1 = (m == 0) ? G3 : acc[ai][0][m - 1 < 0 ? 0 : m - 1][n], gm2 = (m == 0) ? G2 : (m == 1) ? G3 : acc[ai][0][m - 2 < 0 ? 0 : m - 2][n];
                    const f32x4 v1 = (m == 0) ? V3 : acc[ai][1][m - 1 < 0 ? 0 : m - 1][n], vm2 = (m == 0) ? V2 : (m == 1) ? V3 : acc[ai][1][m - 2 < 0 ? 0 : m - 2][n];
                    const f32x4 cgv = W[n][3] + W[n][2] * g0 + W[n][1] * g1 + W[n][0] * gm2;
                    const f32x4 cvv = W[n][7] + W[n][6] * v0 + W[n][5] * v1 + W[n][4] * vm2;
                    unsigned ow[2];
#pragma unroll
                    for (int h = 0; h < 2; ++h) {
                        const f32x2_t x = {cgv[2 * h], cgv[2 * h + 1]}, y = {cvv[2 * h], cvv[2 * h + 1]};
                        const f32x2_t t = x * (x * x * c2 + c1);
                        f32x2_t d; d.x = __builtin_amdgcn_exp2f(t.x); d.y = __builtin_amdgcn_exp2f(t.y); d = d + 1.0f;
                        f32x2_t r; r.x = __builtin_amdgcn_rcpf(d.x); r.y = __builtin_amdgcn_rcpf(d.y);
                        const f32x2_t o = (x * y) * r;
                        ow[h] = pk2(o.x, o.y);
                    }
                    u32x2 w; w.x = ow[0]; w.y = ow[1];
                    *(u32x2*)(Aout + (size_t)(row0 + ai * HALF + m) * FF + u.pn * 128 + tc0 + 4 * n) = w;
                }
                __builtin_amdgcn_sched_barrier(0);
            }
        }
#undef GLU_LOADW
    }
};

template <class Epi, class Sched, bool ALIGN_EPI = false, bool SP2 = false>
__device__ __forceinline__ void gemm_phase(PG8_LAS unsigned char* lds, const Gemm g, const Sched& S, const Epi& E, const int tid) {
    const int wid = __builtin_amdgcn_readfirstlane(tid >> 6), lane = tid & 63, wr = wid >> 2, wc = wid & 3, fr = lane & 15, fq = lane >> 4;
    const int K = g.K, nt = K / BK;
    unsigned voffA[2], voffB[2];
#pragma unroll
    for (int i = 0; i < 2; ++i) { int R, C; stage_rc(tid * 16 + i * 8192, R, C); const int Rb = Epi::PERM ? ((R & ~31) + perm32(R & 31)) : R;
        const int Ra = Epi::APERM ? ((R & 64) + 4 * (R & 15) + ((R >> 4) & 3)) : R;
        voffA[i] = (unsigned)(Ra * g.lda + C) * 2u; voffB[i] = (unsigned)(Rb * g.ldb + C) * 2u; }
    const size_t kstep = (size_t)(BK * 2);
    const size_t hstepA = (size_t)HALF * g.lda * 2, hstepB = (size_t)HALF * g.ldb * 2;
    const size_t tstepA = 2 * hstepA, tstepB = 2 * hstepB;
    const unsigned ldsw = (unsigned)wid * 1024u;
    const int aoff = lds_byte(wr * 64 + fr, fq * 8), boff = lds_byte(wc * 32 + fr, fq * 8);
#define PG8_SA(b, h) (((b) * 2 + (h)) * HTB)
#define PG8_SB(b, h) ((4 + (b) * 2 + (h)) * HTB)
#define PG8_STAGE(bufoff, gbase, voff) do { _Pragma("unroll") for (int _i = 0; _i < 2; ++_i) \
        __builtin_amdgcn_global_load_lds((const unsigned*)((const char*)(gbase) + (voff)[_i]), (PG8_LAS unsigned*)(lds + (bufoff) + ldsw + _i * 8192), 16, 0, 0); } while (0)
#define PG8_LDA(dst, b, h) do { _Pragma("unroll") for (int m = 0; m < 4; ++m) _Pragma("unroll") for (int k = 0; k < 2; ++k) dst[m][k] = *(const PG8_LAS bf16x8*)(lds + PG8_SA(b, h) + aoff + m * 2048 + k * 1024); } while (0)
#define PG8_LDB(dst, b, h) do { _Pragma("unroll") for (int n = 0; n < 2; ++n) _Pragma("unroll") for (int k = 0; k < 2; ++k) dst[n][k] = *(const PG8_LAS bf16x8*)(lds + PG8_SB(b, h) + boff + n * 2048 + k * 1024); } while (0)
#define PG8_MMA(ai, bj, At, Bt) do { __builtin_amdgcn_s_setprio(1); _Pragma("unroll") for (int m = 0; m < 4; ++m) _Pragma("unroll") for (int n = 0; n < 2; ++n) _Pragma("unroll") for (int k = 0; k < 2; ++k) \
        acc[ai][bj][m][n] = __builtin_amdgcn_mfma_f32_16x16x32_bf16(Bt[n][k], At[m][k], acc[ai][bj][m][n], 0, 0, 0); __builtin_amdgcn_s_setprio(0); } while (0)
#define PG8_WAIT_V(n) asm volatile("s_waitcnt vmcnt(" #n ")" ::: "memory")
#define PG8_WAIT_L(n) asm volatile("s_waitcnt lgkmcnt(" #n ")" ::: "memory")
#define PG8_BAR __builtin_amdgcn_s_barrier()
#define PG8_SCHED __builtin_amdgcn_sched_barrier(0)
    Unit cur, nxt; int ui = 0;
    if (!S.next(0, cur)) return;
    f32x4 acc[2][2][4][2];
#pragma unroll
    for (int a = 0; a < 2; ++a)
#pragma unroll
        for (int b = 0; b < 2; ++b)
#pragma unroll
            for (int m = 0; m < 4; ++m)
#pragma unroll
                for (int n = 0; n < 2; ++n) acc[a][b][m][n] = (f32x4){0.f, 0.f, 0.f, 0.f};
    bf16x8 At[4][2], B0[2][2], B1[2][2];
    const char* cA = (const char*)g.A + (size_t)cur.pm * tstepA + (size_t)cur.pn * g.acol * 2; const char* cB = (const char*)g.Bt + (size_t)cur.pn * tstepB;
    S.a_ready(cur);
    if constexpr (SP2) {
        PG8_STAGE(PG8_SB(0, 0), cB, voffB); PG8_STAGE(PG8_SB(0, 1), cB + hstepB, voffB); PG8_STAGE(PG8_SA(0, 0), cA, voffA); PG8_STAGE(PG8_SA(0, 1), cA + hstepA, voffA);
        if (wr == 1) PG8_BAR;
        PG8_WAIT_V(2); PG8_BAR;
        PG8_STAGE(PG8_SB(1, 0), cB + kstep, voffB); PG8_STAGE(PG8_SA(1, 0), cA + kstep, voffA); PG8_STAGE(PG8_SB(1, 1), cB + hstepB + kstep, voffB);
        PG8_WAIT_V(6); PG8_BAR;
    } else {
        PG8_STAGE(PG8_SB(0, 0), cB, voffB); PG8_STAGE(PG8_SA(0, 0), cA, voffA); PG8_STAGE(PG8_SB(0, 1), cB + hstepB, voffB); PG8_STAGE(PG8_SA(0, 1), cA + hstepA, voffA);
        if (wr == 1) PG8_BAR;
        PG8_WAIT_V(4); PG8_BAR;
        PG8_STAGE(PG8_SB(1, 0), cB + kstep, voffB); PG8_STAGE(PG8_SA(1, 0), cA + kstep, voffA); PG8_STAGE(PG8_SB(1, 1), cB + hstepB + kstep, voffB);
        PG8_WAIT_V(6); PG8_BAR;
    }
    for (;;) {
        const bool has_next = S.next(ui + 1, nxt);
        const char* nA = has_next ? (const char*)g.A + (size_t)nxt.pm * tstepA + (size_t)nxt.pn * g.acol * 2 : cA; const char* nB = has_next ? (const char*)g.Bt + (size_t)nxt.pn * tstepB : cB;
        for (int t = 0; t < nt; t += 2) {
            const bool last = (t == nt - 2);
            const char* a1 = cA + (size_t)(t + 1) * kstep;
            const char* a2 = last ? nA : cA + (size_t)(t + 2) * kstep; const char* b2 = last ? nB : cB + (size_t)(t + 2) * kstep;
            const char* a3 = a2 + kstep; const char* b3 = b2 + kstep;
            if (last && has_next) S.a_ready(nxt);
            if constexpr (SP2) {
            PG8_LDB(B0, 0, 0); PG8_LDB(B1, 0, 1); PG8_SCHED; PG8_LDA(At, 0, 0); PG8_STAGE(PG8_SA(1, 1), a1 + hstepA, voffA);
            PG8_WAIT_V(8); PG8_WAIT_L(0); PG8_BAR; PG8_MMA(0, 0, At, B0); PG8_MMA(0, 1, At, B1); PG8_BAR; PG8_SCHED;
            PG8_LDA(At, 0, 1); PG8_STAGE(PG8_SB(0, 0), b2, voffB); PG8_STAGE(PG8_SB(0, 1), b2 + hstepB, voffB); PG8_STAGE(PG8_SA(0, 0), a2, voffA);
            PG8_WAIT_V(8); PG8_WAIT_L(0); PG8_BAR; PG8_MMA(1, 0, At, B0); PG8_MMA(1, 1, At, B1); PG8_BAR; PG8_SCHED;
            PG8_LDB(B0, 1, 0); PG8_LDB(B1, 1, 1); PG8_SCHED; PG8_LDA(At, 1, 0); PG8_STAGE(PG8_SA(0, 1), a2 + hstepA, voffA);
            PG8_WAIT_V(8); PG8_WAIT_L(0); PG8_BAR; PG8_MMA(0, 0, At, B0); PG8_MMA(0, 1, At, B1); PG8_BAR; PG8_SCHED;
            PG8_LDA(At, 1, 1); PG8_STAGE(PG8_SB(1, 0), b3, voffB); PG8_STAGE(PG8_SB(1, 1), b3 + hstepB, voffB); PG8_STAGE(PG8_SA(1, 0), a3, voffA);
            PG8_WAIT_V(8); PG8_WAIT_L(0); PG8_BAR; PG8_MMA(1, 0, At, B0); PG8_MMA(1, 1, At, B1); PG8_BAR; PG8_SCHED;
            } else {
            PG8_LDB(B0, 0, 0); PG8_SCHED; PG8_LDA(At, 0, 0); PG8_STAGE(PG8_SA(1, 1), a1 + hstepA, voffA);
            PG8_WAIT_L(8); PG8_BAR; PG8_WAIT_L(0); PG8_MMA(0, 0, At, B0); PG8_BAR; PG8_SCHED;
            PG8_LDB(B1, 0, 1); PG8_STAGE(PG8_SB(0, 0), b2, voffB);
            PG8_BAR; PG8_WAIT_L(0); PG8_MMA(0, 1, At, B1); PG8_BAR;
            PG8_LDA(At, 0, 1); PG8_STAGE(PG8_SA(0, 0), a2, voffA);
            PG8_BAR; PG8_WAIT_L(0); PG8_MMA(1, 0, At, B0); PG8_BAR; PG8_SCHED;
            PG8_STAGE(PG8_SB(0, 1), b2 + hstepB, voffB);
            PG8_WAIT_V(6); PG8_BAR; PG8_MMA(1, 1, At, B1); PG8_BAR;
            PG8_LDB(B0, 1, 0); PG8_SCHED; PG8_LDA(At, 1, 0); PG8_STAGE(PG8_SA(0, 1), a2 + hstepA, voffA);
            PG8_WAIT_L(8); PG8_BAR; PG8_WAIT_L(0); PG8_MMA(0, 0, At, B0); PG8_BAR; PG8_SCHED;
            PG8_LDB(B1, 1, 1); PG8_STAGE(PG8_SB(1, 0), b3, voffB);
            PG8_BAR; PG8_WAIT_L(0); PG8_MMA(0, 1, At, B1); PG8_BAR;
            PG8_LDA(At, 1, 1); PG8_STAGE(PG8_SA(1, 0), a3, voffA);
            PG8_BAR; PG8_WAIT_L(0); PG8_MMA(1, 0, At, B0); PG8_BAR; PG8_SCHED;
            PG8_STAGE(PG8_SB(1, 1), b3 + hstepB, voffB);
            PG8_WAIT_V(6); PG8_BAR; PG8_MMA(1, 1, At, B1); PG8_BAR;
            }
        }
        if constexpr (ALIGN_EPI) { if (wr == 0) PG8_BAR; }
        if constexpr (!Epi::AFTER_DRAIN) { E(acc, cur, wr, wc, fr, fq, lds + STAGE_BYTES); S.done(cur); }
        if (!has_next) break;
#pragma unroll
        for (int a = 0; a < 2; ++a)
#pragma unroll
            for (int b = 0; b < 2; ++b)
#pragma unroll
                for (int m = 0; m < 4; ++m)
#pragma unroll
                    for (int n = 0; n < 2; ++n) acc[a][b][m][n] = (f32x4){0.f, 0.f, 0.f, 0.f};
        cur = nxt; cA = nA; cB = nB; ++ui;
        if constexpr (ALIGN_EPI) { if (wr == 1) PG8_BAR; }
    }
    PG8_WAIT_V(0);
    if constexpr (!ALIGN_EPI) { if (wr == 0) PG8_BAR; }
    PG8_BAR;
    if constexpr (Epi::AFTER_DRAIN) { E.fused(acc, cur, wr, wc, fr, fq, lds, wid, lane); S.done(cur); }
#undef PG8_SA
#undef PG8_SB
#undef PG8_STAGE
#undef PG8_LDA
#undef PG8_LDB
#undef PG8_MMA
#undef PG8_WAIT_V
#undef PG8_WAIT_L
#undef PG8_BAR
#undef PG8_SCHED
}
}

constexpr size_t MiB = 1u << 20;
constexpr size_t WS_BT1 = 0;
constexpr size_t WS_BT2 = 44 * MiB;
constexpr size_t WS_BTQKV = 66 * MiB;
constexpr size_t WS_BTO = 71 * MiB;
constexpr size_t WS_BTP = 75 * MiB;
constexpr size_t WS_COS = 76 * MiB, WS_SIN = 80 * MiB;
constexpr size_t WS_SIDE = 84 * MiB;
constexpr size_t WS_XN = 96 * MiB;
constexpr size_t WS_T = 160 * MiB;
constexpr size_t WS_K = 224 * MiB, WS_VT = 240 * MiB;
constexpr size_t WS_A = 256 * MiB;
constexpr size_t WS_CTL = 432 * MiB, CTL_BYTES = 4 * MiB;
constexpr size_t WS_XH = 440 * MiB;
constexpr size_t WS_END = 504 * MiB;
constexpr int CW_SEAM = 16384;

constexpr int LDS_BYTES = 147456;
constexpr int NWAVES = 8;

struct Args {
    const float* x; const int* positions; const float* mix_pre_g; const float* mix_post_g; const float* pool_w; const float* pool_scale;
    const float* kv_norm_g; const float* w_kv; const float* w_q; const float* w_o; const float* sinks; const float* ffn_pre_g; const float* ffn_post_g;
    const float* ffn_w_in; const float* ffn_conv_w; const float* ffn_conv_b; const float* ffn_w_out;
    float* out; unsigned char* ws;
    float inv_freq[32];
    int ph_lo, ph_hi;
};

__device__ __forceinline__ float wave_sum(float v) {
#pragma unroll
    for (int o = 1; o < 64; o <<= 1) v += __shfl_xor(v, o);
    return v;
}

__device__ __forceinline__ void transpose_item(const float* W, int ldw, int k0, int n0, bf16_t* WT, int ldo, int orow0, const float* gk, const float* gn, float cst, LAS float* scr, int lane) {
#pragma unroll 8
    for (int i = 0; i < 32; ++i) { const int kk = 2 * i + (lane >> 5); float v = W[(size_t)(k0 + kk) * ldw + n0 + (lane & 31)]; if (gk) v *= gk[k0 + kk]; scr[kk * 33 + (lane & 31)] = v; }
    asm volatile("s_waitcnt lgkmcnt(0)" ::: "memory");
    const int c = lane & 7;
#pragma unroll
    for (int j = 0; j < 4; ++j) { const int n = (lane >> 3) + 8 * j; const LAS float* s = scr + (8 * c) * 33 + n;
        const float gg = (gn ? gn[n0 + n] : 1.0f) * cst;
        u32x4 o; o.x = pk2(s[0 * 33] * gg, s[1 * 33] * gg); o.y = pk2(s[2 * 33] * gg, s[3 * 33] * gg); o.z = pk2(s[4 * 33] * gg, s[5 * 33] * gg); o.w = pk2(s[6 * 33] * gg, s[7 * 33] * gg);
        *(u32x4*)(WT + (size_t)(orow0 + n) * ldo + k0 + 8 * c) = o; }
    asm volatile("s_waitcnt lgkmcnt(0)" ::: "memory");
}

__device__ __forceinline__ void row_phase(const float* xsrc, const bf16_t* t, const float* g, float* xdst, bf16_t* xn, int gw, int NGW, int lane) {
    f32x4 gv[4];
#pragma unroll
    for (int j = 0; j < 4; ++j) gv[j] = g ? *(const f32x4*)(g + 4 * lane + 256 * j) : (f32x4){0.f, 0.f, 0.f, 0.f};
    f32x4 xv[4], xnx[4]; u32x2 tw[4], tnx[4];
    if (gw < M) {
#pragma unroll
        for (int j = 0; j < 4; ++j) { xv[j] = *(const f32x4*)(xsrc + (size_t)gw * D + 4 * lane + 256 * j); tw[j] = t ? *(const u32x2*)(t + (size_t)gw * D + 4 * lane + 256 * j) : (u32x2){0u, 0u}; }
    }
    for (int m = gw; m < M; m += NGW) {
        const int mn = m + NGW;
        if (mn < M) {
#pragma unroll
            for (int j = 0; j < 4; ++j) { xnx[j] = *(const f32x4*)(xsrc + (size_t)mn * D + 4 * lane + 256 * j); tnx[j] = t ? *(const u32x2*)(t + (size_t)mn * D + 4 * lane + 256 * j) : (u32x2){0u, 0u}; }
        }
        if (t) {
            f32x4 tv[4]; float ss = 0.f;
#pragma unroll
            for (int j = 0; j < 4; ++j) { const u32x2 w = tw[j];
                tv[j] = (f32x4){bf_lo(w.x), bf_hi(w.x), bf_lo(w.y), bf_hi(w.y)}; ss += (tv[j][0] * tv[j][0] + tv[j][1] * tv[j][1]) + (tv[j][2] * tv[j][2] + tv[j][3] * tv[j][3]); }
            const float rs = 1.0f / sqrtf(wave_sum(ss) * (1.0f / D) + RMS_EPS);
#pragma unroll
            for (int j = 0; j < 4; ++j) xv[j] += tv[j] * rs * gv[j];
        }
        if (xdst) {
#pragma unroll
            for (int j = 0; j < 4; ++j) *(f32x4*)(xdst + (size_t)m * D + 4 * lane + 256 * j) = xv[j];
        }
        if (xn) {
            float s2 = 0.f;
#pragma unroll
            for (int j = 0; j < 4; ++j) s2 += (xv[j][0] * xv[j][0] + xv[j][1] * xv[j][1]) + (xv[j][2] * xv[j][2] + xv[j][3] * xv[j][3]);
            const float r2 = 1.0f / sqrtf(wave_sum(s2) * (1.0f / D) + RMS_EPS);
#pragma unroll
            for (int j = 0; j < 4; ++j) { u32x2 w; w.x = pk2(xv[j][0] * r2, xv[j][1] * r2); w.y = pk2(xv[j][2] * r2, xv[j][3] * r2); *(u32x2*)(xn + (size_t)m * D + 4 * lane + 256 * j) = w; }
        }
#pragma unroll
        for (int j = 0; j < 4; ++j) { xv[j] = xnx[j]; tw[j] = tnx[j]; }
    }
}

__device__ __forceinline__ void add8(float (&a)[8], const u32x4 v, float sgn) {
    a[0] += sgn * bf_lo(v.x); a[1] += sgn * bf_hi(v.x); a[2] += sgn * bf_lo(v.y); a[3] += sgn * bf_hi(v.y); a[4] += sgn * bf_lo(v.z); a[5] += sgn * bf_hi(v.z); a[6] += sgn * bf_lo(v.w); a[7] += sgn * bf_hi(v.w);
}
__device__ __forceinline__ void diff_phase(const bf16_t* xn, bf16_t* dd, int gtid, int NT) {
    for (int item = gtid; item < (M / 32) * 128; item += NT) {
        const int c = item & 127, t0 = (item >> 7) * 32, ts0 = t0 & (SEQ - 1), grp = c >> 5, w = 2 << grp;
        const bf16_t* base = xn + (size_t)t0 * D + 8 * c;
        float S[8] = {0.f, 0.f, 0.f, 0.f, 0.f, 0.f, 0.f, 0.f};
#pragma unroll
        for (int k = 1; k < 16; ++k) { if (k < w && ts0 - k >= 0) add8(S, *(const u32x4*)(base - (size_t)k * D), 1.0f); }
#pragma unroll 1
        for (int i0 = 0; i0 < 32; i0 += 8) {
            u32x4 cur[8], old[8];
#pragma unroll
            for (int i = 0; i < 8; ++i) { cur[i] = *(const u32x4*)(base + (size_t)(i0 + i) * D);
                old[i] = (i0 + i > 0 && ts0 + i0 + i - w >= 0) ? *(const u32x4*)(base + (size_t)(i0 + i - w) * D) : (u32x4){0u, 0u, 0u, 0u}; }
#pragma unroll
            for (int i = 0; i < 8; ++i) {
                if (i0 + i > 0) add8(S, old[i], -1.0f);
                add8(S, cur[i], 1.0f);
                const int ts = ts0 + i0 + i; const float ic = 1.0f / (float)((ts + 1) < w ? (ts + 1) : w);
                const u32x4 v = cur[i];
                u32x4 o; o.x = pk2(S[0] * ic - bf_lo(v.x), S[1] * ic - bf_hi(v.x)); o.y = pk2(S[2] * ic - bf_lo(v.y), S[3] * ic - bf_hi(v.y));
                o.z = pk2(S[4] * ic - bf_lo(v.z), S[5] * ic - bf_hi(v.z)); o.w = pk2(S[6] * ic - bf_lo(v.w), S[7] * ic - bf_hi(v.w));
                *(u32x4*)(dd + (size_t)(t0 + i0 + i) * D + 8 * c) = o;
            }
        }
    }
}

__device__ __forceinline__ void fixup_phase(const float* side, const float* cw, const float* cb, bf16_t* Aout, int gtid, int NT) {
    for (int idx = gtid; idx < 128 * 2 * (FF / 4); idx += NT) {
        const int c = 4 * (idx % (FF / 4)), i = (idx / (FF / 4)) & 1, pm = idx / (2 * (FF / 4));
        const int sc = (c >> 7) * 256 + (c & 127);
        const f32x4 z = (f32x4){0.f, 0.f, 0.f, 0.f};
        const bool first = (pm & 15) == 0;
        const float* sp = side + (size_t)pm * 4 * FF2 + sc; const float* pp = sp - 4 * FF2;
        f32x4 o;
        {
            const f32x4 gm2 = first ? z : *(const f32x4*)(pp + 2 * FF2), gm1 = first ? z : *(const f32x4*)(pp + 3 * FF2), g0 = *(const f32x4*)(sp), g1 = *(const f32x4*)(sp + FF2);
            const f32x4 vm2 = first ? z : *(const f32x4*)(pp + 2 * FF2 + 128), vm1 = first ? z : *(const f32x4*)(pp + 3 * FF2 + 128), v0 = *(const f32x4*)(sp + 128), v1 = *(const f32x4*)(sp + FF2 + 128);
            const f32x4 wg0 = *(const f32x4*)(cw + c), wg1 = *(const f32x4*)(cw + FF2 + c), wg2 = *(const f32x4*)(cw + 2 * FF2 + c), bg = *(const f32x4*)(cb + c);
            const f32x4 wv0 = *(const f32x4*)(cw + FF + c), wv1 = *(const f32x4*)(cw + FF2 + FF + c), wv2 = *(const f32x4*)(cw + 2 * FF2 + FF + c), bv = *(const f32x4*)(cb + FF + c);
            const f32x4 cgv = (i == 0) ? (wg2 * g0 + wg1 * gm1 + wg0 * gm2 + bg) : (wg2 * g1 + wg1 * g0 + wg0 * gm1 + bg);
            const f32x4 cvv = (i == 0) ? (wv2 * v0 + wv1 * vm1 + wv0 * vm2 + bv) : (wv2 * v1 + wv1 * v0 + wv0 * vm1 + bv);
#pragma unroll
            for (int e = 0; e < 4; ++e) o[e] = gelu_tanh(cgv[e]) * cvv[e];
        }
        u32x2 w; w.x = pk2(o[0], o[1]); w.y = pk2(o[2], o[3]);
        *(u32x2*)(Aout + (size_t)(pm * 256 + i) * FF + c) = w;
    }
}

constexpr int AT_KROW = 144, AT_VROW = 528, AT_VOFF = 256 * AT_KROW;
__device__ __forceinline__ void attn_phase(LAS unsigned char* lds, const bf16_t* Q, const bf16_t* Kb, const bf16_t* Vt, bf16_t* O, const float* sinks, int blk, int G, int wave, int lane, int tid) {
    const int q = lane & 31, hi = lane >> 5;
    const int NU = BATCH * NKVH * 32, UPB = (NU + G - 1) / G;
    u32x4 kr[4], vr[4];
#define AT_LOAD(u_) do { const int b_ = (u_) >> 7, hk_ = ((u_) >> 5) & 3, nb_ = (u_) & 31; \
        int kp_ = nb_ * 128 - 128 + (tid >> 1); if (kp_ < 0) kp_ += 128; \
        int vp_ = nb_ * 128 - 128 + (tid & 7) * 32; if (vp_ < 0) vp_ += 128; \
        const bf16_t* ks_ = Kb + (size_t)(b_ * SEQ + kp_) * 256 + hk_ * 64 + (tid & 1) * 32; \
        const bf16_t* vs_ = Vt + ((size_t)((b_ * NKVH + hk_) * HD + (tid >> 3))) * SEQ + vp_; \
        _Pragma("unroll") for (int j_ = 0; j_ < 4; ++j_) { kr[j_] = *(const u32x4*)(ks_ + j_ * 8); vr[j_] = *(const u32x4*)(vs_ + j_ * 8); } } while (0)
    for (int i = 0; i < UPB; ++i) {
        const int u = blk * UPB + i; if (u >= NU) break;
        const int b = u >> 7, hk = (u >> 5) & 3, nb = u & 31;
        if (i == 0) AT_LOAD(u);
        __syncthreads();
#pragma unroll
        for (int j = 0; j < 4; ++j) { *(LAS u32x4*)(lds + (tid >> 1) * AT_KROW + (tid & 1) * 64 + j * 16) = kr[j]; *(LAS u32x4*)(lds + AT_VOFF + (tid >> 3) * AT_VROW + (tid & 7) * 64 + j * 16) = vr[j]; }
        __syncthreads();
        if (i + 1 < UPB && u + 1 < NU) AT_LOAD(u + 1);
        const int gq = wave >> 1, hq = hk * 4 + gq;
        const float sink2 = sinks[hq] * LOG2E;
#pragma unroll 1
        for (int t = 0; t < 2; ++t) {
            const int sb = 2 * (wave & 1) + t;
            const int row0 = b * SEQ + nb * 128 + sb * 32;
            bf16x8 qf[4];
            { const bf16_t* qp = Q + (size_t)(row0 + q) * D + hq * 64 + hi * 8;
#pragma unroll
              for (int s = 0; s < 4; ++s) qf[s] = *(const bf16x8*)(qp + s * 16); }
            f32x16 st[5];
            const LAS unsigned char* kl = lds + (32 * sb + q) * AT_KROW + hi * 16;
#pragma unroll
            for (int kbi = 0; kbi < 5; ++kbi) {
                f32x16 a = {};
#pragma unroll
                for (int s = 0; s < 4; ++s) { const bf16x8 kf = *(const LAS bf16x8*)(kl + kbi * 32 * AT_KROW + s * 32); a = __builtin_amdgcn_mfma_f32_32x32x16_bf16(kf, qf[s], a, 0, 0, 0); }
                st[kbi] = a;
            }
            const float NEG = -1e30f;
#pragma unroll
            for (int kbi = 0; kbi < 5; ++kbi) {
                const bool dead = (nb == 0) && (sb + kbi < 4);
#pragma unroll
                for (int r = 0; r < 16; ++r) {
                    const int kk = (r & 3) + 8 * (r >> 2) + 4 * hi;
                    bool ok = !dead;
                    if (kbi == 0) ok = ok && (kk > q);
                    if (kbi == 4) ok = ok && (kk <= q);
                    st[kbi][r] = ok ? st[kbi][r] : NEG;
                }
            }
            float mx = sink2;
#pragma unroll
            for (int kbi = 0; kbi < 5; ++kbi)
#pragma unroll
                for (int r = 0; r < 16; ++r) mx = fmaxf(mx, st[kbi][r]);
            mx = fmaxf(mx, __shfl_xor(mx, 32));
            float sum = 0.f;
            bf16x8 pw[5][2];
#pragma unroll
            for (int kbi = 0; kbi < 5; ++kbi) {
                float p[16];
#pragma unroll
                for (int r = 0; r < 16; ++r) { p[r] = __builtin_amdgcn_exp2f(st[kbi][r] - mx); sum += p[r]; }
#pragma unroll
                for (int h = 0; h < 2; ++h) { u32x4 w; w.x = pk2(p[8 * h + 0], p[8 * h + 1]); w.y = pk2(p[8 * h + 2], p[8 * h + 3]); w.z = pk2(p[8 * h + 4], p[8 * h + 5]); w.w = pk2(p[8 * h + 6], p[8 * h + 7]);
                    pw[kbi][h] = __builtin_bit_cast(bf16x8, w); }
            }
            sum += __shfl_xor(sum, 32);
            const float inv = 1.0f / (sum + __builtin_amdgcn_exp2f(sink2 - mx));
            f32x16 ot[2]; ot[0] = f32x16{}; ot[1] = f32x16{};
            const LAS unsigned char* vl = lds + AT_VOFF + q * AT_VROW + (32 * sb + hi * 8) * 2;
#pragma unroll
            for (int kbi = 0; kbi < 5; ++kbi)
#pragma unroll
                for (int h = 0; h < 2; ++h)
#pragma unroll
                    for (int dh = 0; dh < 2; ++dh) {
                        const bf16x8 vf = *(const LAS bf16x8*)(vl + dh * 32 * AT_VROW + (kbi * 32 + h * 16) * 2);
                        ot[dh] = __builtin_amdgcn_mfma_f32_32x32x16_bf16(vf, pw[kbi][h], ot[dh], 0, 0, 0);
                    }
            bf16_t* op = O + (size_t)(row0 + q) * D + hq * 64 + 4 * hi;
#pragma unroll
            for (int dh = 0; dh < 2; ++dh)
#pragma unroll
                for (int rg = 0; rg < 4; ++rg) { u32x2 w; w.x = pk2(ot[dh][4 * rg + 0] * inv, ot[dh][4 * rg + 1] * inv); w.y = pk2(ot[dh][4 * rg + 2] * inv, ot[dh][4 * rg + 3] * inv);
                    *(u32x2*)(op + dh * 32 + 8 * rg) = w; }
        }
    }
#undef AT_LOAD
    __syncthreads();
}

#define XB_TMO      128
#define XB_XCNT(j)  (256  + 64 * (j))
#define XB_XSUB(j)  (1280 + 64 * (j))
#define XB_XGEN(j)  (2304 + 64 * (j))
#define XB_TOP      3328
#define XB_TOPGEN   3392
#define XCD_BAR_WORDS 3456
#define XB_SPIN_CAP (1u << 18)

__device__ __forceinline__ unsigned xb_ld(unsigned* p)              { return __hip_atomic_load(p, __ATOMIC_RELAXED, __HIP_MEMORY_SCOPE_AGENT); }
__device__ __forceinline__ unsigned xb_add(unsigned* p, unsigned v) { return __hip_atomic_fetch_add(p, v, __ATOMIC_RELAXED, __HIP_MEMORY_SCOPE_AGENT); }
__device__ __forceinline__ unsigned xb_xcc_id() { return (unsigned)__builtin_amdgcn_s_getreg((3 << 11) | 20) & 0xFu; }
#define XB_SPIN(cond, bar) do { unsigned _sp = 0; while (cond) { __builtin_amdgcn_s_sleep(1); \
    if ((++_sp & 255u) == 0u) { if (xb_ld(&(bar)[XB_TMO])) break; if (_sp > XB_SPIN_CAP) { atomicAdd(&(bar)[XB_TMO], 1u); break; } } } } while (0)

struct XcdBarrier {
    unsigned* bar; unsigned x;
    volatile LAS unsigned* st;
};

__device__ __forceinline__ XcdBarrier xcd_barrier_post(unsigned* bar, volatile LAS unsigned* st) {
    XcdBarrier b; b.bar = bar; b.x = xb_xcc_id(); b.st = st;
    if (threadIdx.x == 0) (void)xb_add(&bar[XB_XCNT(b.x)], 1u);
    return b;
}
__device__ __forceinline__ void xcd_barrier_complete(unsigned* bar, unsigned x, unsigned& nloc, unsigned& nx) {
    const unsigned G = gridDim.x * gridDim.y * gridDim.z;
    unsigned sum, cnt, mine, sp = 0u;
    for (;;) {
        sum = 0u; cnt = 0u; mine = 0u;
#pragma unroll
        for (unsigned j = 0; j < 16; ++j) { const unsigned c = xb_ld(&bar[XB_XCNT(j)]); sum += c; cnt += (c > 0u) ? 1u : 0u; mine = (j == x) ? c : mine; }
        if (sum == G) break;
        __builtin_amdgcn_s_sleep(1);
        if ((++sp & 255u) == 0u) { if (xb_ld(&bar[XB_TMO])) break; if (sp > XB_SPIN_CAP) { atomicAdd(&bar[XB_TMO], 1u); break; } }
    }
    nloc = mine > 0u ? mine : 1u; nx = cnt > 0u ? cnt : 1u;
}

__device__ __forceinline__ void xcd_barrier(const XcdBarrier& b) {
    asm volatile("s_waitcnt vmcnt(0)" ::: "memory");
    __syncthreads();
    if (threadIdx.x == 0) {
        unsigned* bar = b.bar;
        __builtin_amdgcn_s_waitcnt(0);
        unsigned nloc = b.st[0], nx = b.st[1];
        if (nloc == 0u) { xcd_barrier_complete(bar, b.x, nloc, nx); b.st[0] = nloc; b.st[1] = nx; }
        const unsigned old = xb_add(&bar[XB_XSUB(b.x)], 1u);
        const unsigned gen = old / nloc;
        if (old + 1u == (gen + 1u) * nloc) {
            __builtin_amdgcn_fence(__ATOMIC_RELEASE, "agent");
            asm volatile("s_waitcnt vmcnt(0)" ::: "memory");
            const unsigned og = xb_add(&bar[XB_TOP], 1u);
            const unsigned tg = og / nx;
            if (og + 1u == (tg + 1u) * nx) xb_add(&bar[XB_TOPGEN], 1u);
            else XB_SPIN(xb_ld(&bar[XB_TOPGEN]) == tg, bar);
            __builtin_amdgcn_fence(__ATOMIC_ACQUIRE, "agent");
            xb_add(&bar[XB_XGEN(b.x)], 1u);
            asm volatile("s_waitcnt vmcnt(0)" ::: "memory");
        } else {
            XB_SPIN(xb_ld(&bar[XB_XGEN(b.x)]) == gen, bar);
            __builtin_amdgcn_fence(__ATOMIC_ACQUIRE, "agent");
            asm volatile("s_waitcnt vmcnt(0)" ::: "memory");
        }
    }
    __syncthreads();
}

enum { T_PRO = 0, T_ROWA, T_DIFF, T_POOLG, T_ROWB, T_QKV, T_ATTN, T_WO, T_GLU, T_FIX, T_DOWN };
constexpr int NPH = 23;
__host__ __device__ __forceinline__ void decode_phase(int ph, int& type, int& layer) {
    if (ph == 0) { type = T_PRO; layer = 0; return; }
    if (ph <= 10) { const int k = (ph - 1) % 5; layer = (ph - 1) / 5; type = (int)((0xA9832ull >> (4 * k)) & 15); return; }
    const int k = (ph - 11) % 6; layer = 2 + (ph - 11) / 6; type = (int)((0xA98765ull >> (4 * k)) & 15);
}
#ifndef PH_MASK
#define PH_MASK 0xFFFF
#endif
#define PH_ON(t) (((PH_MASK) >> (t)) & 1)
template <bool COOP>
__global__ void __launch_bounds__(NWAVES * 64, 2) yoco_fwd(Args a) {
    extern __shared__ __attribute__((aligned(16))) unsigned char lds_raw[];
    LAS unsigned char* lds = (LAS unsigned char*)lds_raw;
    const int G = gridDim.x, blk = blockIdx.x;
    const int wave_s = __builtin_amdgcn_readfirstlane(threadIdx.x >> 6);
    volatile LAS unsigned* MISC = (volatile LAS unsigned*)(lds + pg8::STAGE_BYTES + 8192);
    if (threadIdx.x < 16) MISC[threadIdx.x] = 0u;
    __syncthreads();
    XcdBarrier xbar; xbar.bar = (unsigned*)(a.ws + WS_CTL); xbar.x = 0; xbar.st = nullptr;
    if constexpr (COOP) xbar = xcd_barrier_post((unsigned*)(a.ws + WS_CTL), MISC + 8);
    int ph0 = a.ph_lo;
    if (PH_ON(T_PRO) && ph0 == 0) {
        int lane = __builtin_amdgcn_mbcnt_hi(~0u, __builtin_amdgcn_mbcnt_lo(~0u, 0u)); asm volatile("" : "+v"(lane));
        const int wave = wave_s, tid = wave * 64 + lane;
        const int gw = blk * NWAVES + wave, NGW = G * NWAVES;
        unsigned char* ws = a.ws; asm volatile("" : "+s"(ws));
        bf16_t* BT1 = (bf16_t*)(ws + WS_BT1); bf16_t* BT2 = (bf16_t*)(ws + WS_BT2); bf16_t* BTQKV = (bf16_t*)(ws + WS_BTQKV); bf16_t* BTO = (bf16_t*)(ws + WS_BTO); bf16_t* BTP = (bf16_t*)(ws + WS_BTP);
        float* COSB = (float*)(ws + WS_COS); float* SINB = (float*)(ws + WS_SIN); bf16_t* XN = (bf16_t*)(ws + WS_XN);
        {
            LAS float* scr = (LAS float*)(lds + wave * 16384);
            constexpr int I_IN = 16 * 176, I_OUT = 44 * 32, I_Q = 16 * 32, I_KV = 16 * 16, I_O = 16 * 32, I_P = 4 * 8;
            constexpr int NITEMS = 4 * I_IN + 4 * I_OUT + 2 * I_Q + I_KV + 2 * I_O + 8 * I_P;
            for (int it = gw; it < NITEMS; it += NGW) {
                int r = it;
                if (r < 4 * I_IN) { const int l = r / I_IN; r %= I_IN; const int kb = r / 176, nbk = r % 176, n0 = nbk * 32;
                    const int bj = n0 / FF, rem = n0 % FF, pn = rem / 128, j = rem % 128;
                    transpose_item(a.ffn_w_in + (size_t)l * D * FF2, FF2, kb * 64, n0, BT1 + (size_t)l * FF2 * D, D, pn * 256 + bj * 128 + j, a.ffn_pre_g + l * D, nullptr, 1.0f, scr, lane); continue; }
                r -= 4 * I_IN;
                if (r < 4 * I_OUT) { const int l = r / I_OUT; r %= I_OUT; const int kb = r / 32, nbk = r % 32;
                    transpose_item(a.ffn_w_out + (size_t)l * FF * D, D, kb * 64, nbk * 32, BT2 + (size_t)l * D * FF, FF, nbk * 32, nullptr, nullptr, 1.0f, scr, lane); continue; }
                r -= 4 * I_OUT;
                if (r < 2 * I_Q) { const int j2 = r / I_Q; r %= I_Q; const int kb = r / 32, nbk = r % 32, n0 = nbk * 32;
                    const int head = n0 >> 6, half = (n0 >> 5) & 1;
                    transpose_item(a.w_q + (size_t)j2 * D * D, D, kb * 64, n0, BTQKV + (size_t)j2 * NQKV * D, D, (head >> 2) * 256 + half * 128 + (head & 3) * 32, a.mix_pre_g + (2 + j2) * D, nullptr, 0.125f * LOG2E, scr, lane); continue; }
                r -= 2 * I_Q;
                if (r < I_KV) { const int kb = r / 16, nbk = r % 16, n0 = nbk * 32;
                    int orow; if (n0 < 256) { const int head = n0 >> 6, half = (n0 >> 5) & 1; orow = 1024 + half * 128 + head * 32; } else orow = 1280 + (n0 - 256);
                    transpose_item(a.w_kv, 512, kb * 64, n0, BTQKV, D, orow, a.kv_norm_g, nullptr, 1.0f, scr, lane); continue; }
                r -= I_KV;
                if (r < 2 * I_O) { const int j2 = r / I_O; r %= I_O; const int kb = r / 32, nbk = r % 32;
                    transpose_item(a.w_o + (size_t)j2 * D * D, D, kb * 64, nbk * 32, BTO + (size_t)j2 * D * D, D, nbk * 32, nullptr, nullptr, 1.0f, scr, lane); continue; }
                r -= 2 * I_O;
                { const int lg = r / I_P; r %= I_P; const int l = lg >> 2, grp = lg & 3, kb = r / 8, nbk = r % 8;
                    transpose_item(a.pool_w + (size_t)lg * 256 * 256, 256, kb * 64, nbk * 32, BTP + (size_t)l * D * 256, 256, grp * 256 + nbk * 32, a.mix_pre_g + l * D + grp * 256, a.pool_scale + l * D + grp * 256, 1.0f, scr, lane); }
            }
            for (int idx = blk * (NWAVES * 64) + tid; idx < M * 32; idx += G * NWAVES * 64) {
                const int row = idx >> 5, i = idx & 31;
                const float ang = (float)a.positions[row] * a.inv_freq[i];
                const double ad = (double)ang; const double kq = rint(ad * 0.63661977236758134308); const double rr = ad - kq * 1.57079632679489661923;
                const double r2 = rr * rr;
                const double sv = rr * (1.0 + r2 * (-1.0 / 6 + r2 * (1.0 / 120 + r2 * (-1.0 / 5040 + r2 * (1.0 / 362880 + r2 * (-1.0 / 39916800 + r2 * (1.0 / 6227020800.0)))))));
                const double cv = 1.0 + r2 * (-0.5 + r2 * (1.0 / 24 + r2 * (-1.0 / 720 + r2 * (1.0 / 40320 + r2 * (-1.0 / 3628800 + r2 * (1.0 / 479001600.0 + r2 * (-1.0 / 87178291200.0)))))));
                const int qd = ((int)kq) & 3;
                const double c = (qd == 0) ? cv : (qd == 1) ? -sv : (qd == 2) ? -cv : sv;
                const double s = (qd == 0) ? sv : (qd == 1) ? cv : (qd == 2) ? -sv : -cv;
                COSB[idx] = (float)c; SINB[idx] = (float)s;
            }
            row_phase(a.x, nullptr, nullptr, nullptr, XN, gw, NGW, lane);
        }
        ph0 = 1;
        if (ph0 < a.ph_hi) { if constexpr (COOP) { cg::this_grid().sync(); } }
    }
    int rep = 0; (void)rep;
    for (int ph = ph0 < 1 ? 1 : ph0; ph < a.ph_hi; ++ph) {
        int type, layer; decode_phase(ph, type, layer);
        unsigned ones = ~0u; asm volatile("" : "+s"(ones));
        int lane = __builtin_amdgcn_mbcnt_hi(ones, __builtin_amdgcn_mbcnt_lo(ones, 0u)); asm volatile("" : "+v"(lane));
        const int wave = wave_s, tid = wave * 64 + lane;
        const int gw = blk * NWAVES + wave, NGW = G * NWAVES;
        unsigned char* ws = a.ws; asm volatile("" : "+s"(ws));
        bf16_t* BT1 = (bf16_t*)(ws + WS_BT1); bf16_t* BT2 = (bf16_t*)(ws + WS_BT2); bf16_t* BTQKV = (bf16_t*)(ws + WS_BTQKV); bf16_t* BTO = (bf16_t*)(ws + WS_BTO); bf16_t* BTP = (bf16_t*)(ws + WS_BTP);
        float* COSB = (float*)(ws + WS_COS); float* SINB = (float*)(ws + WS_SIN); float* SIDE = (float*)(ws + WS_SIDE);
        bf16_t* XN = (bf16_t*)(ws + WS_XN); bf16_t* TB = (bf16_t*)(ws + WS_T); bf16_t* KB = (bf16_t*)(ws + WS_K); bf16_t* VT = (bf16_t*)(ws + WS_VT);
        bf16_t* AB = (bf16_t*)(ws + WS_A); bf16_t* DB = AB; bf16_t* QO = AB; bf16_t* OB = AB + (size_t)M * D;
        if (false) {
        } else if (PH_ON(T_DIFF) && type == T_DIFF) {
            diff_phase(XN, DB, blk * (NWAVES * 64) + tid, G * NWAVES * 64);
        } else if (PH_ON(T_FIX) && type == T_FIX) {
            fixup_phase(SIDE, a.ffn_conv_w + (size_t)layer * 3 * FF2, a.ffn_conv_b + (size_t)layer * FF2, AB, blk * (NWAVES * 64) + tid, G * NWAVES * 64);
        } else if (PH_ON(T_ATTN) && type == T_ATTN) {
            attn_phase(lds, QO, KB, VT, OB, a.sinks + (layer - 2) * NQH, blk, G, wave, lane, tid);
        } else if (PH_ON(T_GLU) && type == T_GLU) {
            pg8::Gemm g{XN, BT1 + (size_t)layer * FF2 * D, D, D, D, 0}; pg8::StaticOrder S; S.init(M, FF2, G, blk);
            pg8::EpiGlu E{AB, a.ffn_conv_w + (size_t)layer * 3 * FF2, a.ffn_conv_b + (size_t)layer * FF2, SIDE};
            pg8::gemm_phase<pg8::EpiGlu, pg8::StaticOrder, true, true>(lds, g, S, E, tid);
        } else if (PH_ON(T_QKV) && type == T_QKV) {
            pg8::Gemm g{XN, BTQKV + (size_t)(layer - 2) * NQKV * D, D, D, D, 0}; pg8::StaticOrder S; S.init(M, layer == 2 ? NQKV : D, G, blk);
            pg8::EpiQKV E{QO, KB, VT, COSB, SINB};
            pg8::gemm_phase<pg8::EpiQKV, pg8::StaticOrder, true, true>(lds, g, S, E, tid);
        } else if (PH_ON(T_DOWN)) {
            pg8::Gemm g; const float* gain; const void* xs = (const void*)(ws + WS_XH); void* xd = (void*)(ws + WS_XH); int s16 = 1, d16 = 1; bf16_t* xno = XN;
            if (type == T_POOLG) { g = pg8::Gemm{DB, BTP + (size_t)layer * D * 256, D, 256, 256, 256}; gain = a.mix_post_g + layer * D; if (layer == 0) { xs = (const void*)a.x; s16 = 0; } }
            else if (type == T_WO) { g = pg8::Gemm{OB, BTO + (size_t)(layer - 2) * D * D, D, D, D, 0}; gain = a.mix_post_g + layer * D; }
            else { g = pg8::Gemm{AB, BT2 + (size_t)layer * D * FF, FF, FF, FF, 0}; gain = a.ffn_post_g + layer * D; if (layer == DEPTH - 1) { xno = nullptr; xd = (void*)a.out; d16 = 0; } }
            pg8::StaticOrder S; S.init(M, D, G, blk);
            unsigned* ctl = (unsigned*)(ws + WS_CTL);
            int bank = 2 * ph;
#if defined(PROBE_DUP)
            if ((((PROBE_DUP) >> type) & 1) && rep == 0) { gain = (const float*)(ws + WS_CTL + 3584 * 1024); bank += 46; }
#endif
            pg8::RowStats st1{(float*)(ws + WS_T), ctl + CW_SEAM + bank * 8192}, st2{(float*)(ws + WS_T) + (size_t)M * 4, ctl + CW_SEAM + (bank + 1) * 8192};
            pg8::EpiResNorm E{xs, xd, s16, d16, xno, gain, st1, st2};
            pg8::gemm_phase<pg8::EpiResNorm, pg8::StaticOrder, true, true>(lds, g, S, E, tid);
        }
        if (ph + 1 < a.ph_hi) {
            if constexpr (COOP) { xcd_barrier(xbar); }
        }
#if defined(PROBE_DUP)
        if ((((PROBE_DUP) >> type) & 1) && rep == 0) { rep = 1; --ph; } else rep = 0;
#endif
    }
}

extern "C" void kernel_launch(void* const* d_in, const int* in_sizes, int n_in, void* d_out, int out_size, void* d_ws, size_t ws_size, hipStream_t stream) {
    static int grid = 0;
    static float invf[32];
    if (grid == 0) {
        if (n_in != 17 || out_size != M * D || ws_size < WS_END) { fprintf(stderr, "kernel_launch: unexpected shapes (n_in %d, out %d, ws %zu)\n", n_in, out_size, ws_size); grid = -1; return; }
        int dev = 0, cus = 0, per_cu = 0;
        (void)hipGetDevice(&dev); (void)hipDeviceGetAttribute(&cus, hipDeviceAttributeMultiprocessorCount, dev);
#if defined(MK_PER_PHASE)
        const void* kfn = (const void*)yoco_fwd<false>;
#else
        const void* kfn = (const void*)yoco_fwd<true>;
#endif
        (void)hipFuncSetAttribute(kfn, hipFuncAttributeMaxDynamicSharedMemorySize, LDS_BYTES);
        (void)hipOccupancyMaxActiveBlocksPerMultiprocessor(&per_cu, kfn, NWAVES * 64, LDS_BYTES);
        if (per_cu < 1) { fprintf(stderr, "kernel_launch: occupancy query says %d blocks per CU\n", per_cu); per_cu = 1; }
        (void)hipGetLastError();
        grid = cus * per_cu;
        for (int i = 0; i < 32; ++i) invf[i] = 1.0f / powf(10000.0f, (float)(2 * i) / 64.0f);
    }
    if (grid < 0) return;
    Args a{};
    a.x = (const float*)d_in[0]; a.positions = (const int*)d_in[1]; a.mix_pre_g = (const float*)d_in[2]; a.mix_post_g = (const float*)d_in[3]; a.pool_w = (const float*)d_in[4];
    a.pool_scale = (const float*)d_in[5]; a.kv_norm_g = (const float*)d_in[6]; a.w_kv = (const float*)d_in[7]; a.w_q = (const float*)d_in[8]; a.w_o = (const float*)d_in[9];
    a.sinks = (const float*)d_in[10]; a.ffn_pre_g = (const float*)d_in[11]; a.ffn_post_g = (const float*)d_in[12]; a.ffn_w_in = (const float*)d_in[13]; a.ffn_conv_w = (const float*)d_in[14];
    a.ffn_conv_b = (const float*)d_in[15]; a.ffn_w_out = (const float*)d_in[16];
    a.out = (float*)d_out; a.ws = (unsigned char*)d_ws;
    for (int i = 0; i < 32; ++i) a.inv_freq[i] = invf[i];
#if defined(MK_PER_PHASE)
    for (int ph = 0; ph < NPH; ++ph) { a.ph_lo = ph; a.ph_hi = ph + 1; hipLaunchKernelGGL(yoco_fwd<false>, dim3(grid), dim3(NWAVES * 64), LDS_BYTES, stream, a); }
#else
    a.ph_lo = 0; a.ph_hi = NPH;
    (void)hipMemsetAsync((char*)d_ws + WS_CTL, 0, CTL_BYTES, stream);
    void* args[] = {&a};
    hipError_t e = hipLaunchCooperativeKernel((const void*)yoco_fwd<true>, dim3(grid), dim3(NWAVES * 64), args, LDS_BYTES, stream);
    if (e != hipSuccess) fprintf(stderr, "cooperative launch failed: %s (grid %d)\n", hipGetErrorString(e), grid);
#endif
}
```

```cpp
#include <hip/hip_runtime.h>
#include <hip/hip_cooperative_groups.h>
#include <cstdio>
#include <cstdint>
#include <cmath>
namespace cg = cooperative_groups;

#define LAS __attribute__((address_space(3)))
#define PG8_LAS LAS
typedef unsigned short bf16_t;
typedef short bf16x8 __attribute__((ext_vector_type(8)));
typedef float f32x4 __attribute__((ext_vector_type(4)));
typedef float f32x16 __attribute__((ext_vector_type(16)));
typedef unsigned u32x4 __attribute__((ext_vector_type(4)));
typedef unsigned u32x2 __attribute__((ext_vector_type(2)));
typedef float f32x2_t __attribute__((ext_vector_type(2)));
typedef __bf16 bf16x2_t __attribute__((ext_vector_type(2)));

constexpr int D = 1024, BATCH = 8, SEQ = 4096, M = BATCH * SEQ, DEPTH = 4, NA = 2, FF = 2816, FF2 = 5632;
constexpr int HD = 64, NQH = 16, NKVH = 4, NQKV = 1536;
constexpr float RMS_EPS = 1e-6f;
constexpr float LOG2E = 1.4426950408889634f;

__device__ __forceinline__ unsigned pk2(float lo, float hi) { f32x2_t v = {lo, hi}; bf16x2_t b = __builtin_convertvector(v, bf16x2_t); return __builtin_bit_cast(unsigned, b); }
typedef _Float16 h16x2 __attribute__((ext_vector_type(2)));
__device__ __forceinline__ unsigned pkh2(float lo, float hi) { h16x2 h = {(_Float16)lo, (_Float16)hi}; return __builtin_bit_cast(unsigned, h); }
__device__ __forceinline__ float h_lo(unsigned u) { return (float)__builtin_bit_cast(h16x2, u).x; }
__device__ __forceinline__ float h_hi(unsigned u) { return (float)__builtin_bit_cast(h16x2, u).y; }
__device__ __forceinline__ float bf_lo(unsigned u) { return __builtin_bit_cast(float, u << 16); }
__device__ __forceinline__ float bf_hi(unsigned u) { return __builtin_bit_cast(float, u & 0xffff0000u); }
template <int CTRL> __device__ __forceinline__ float dppf(float old, float src) {
    return __builtin_bit_cast(float, __builtin_amdgcn_update_dpp(__builtin_bit_cast(int, old), __builtin_bit_cast(int, src), CTRL, 0xf, 0xf, false));
}
constexpr int DPP_SHR1 = 0x111, DPP_SHR2 = 0x112, DPP_ROR1 = 0x121, DPP_ROR2 = 0x122;
__device__ __forceinline__ float gelu_tanh(float x) {
    const float c1 = -2.0f * 0.7978845608028654f * LOG2E, c2 = c1 * 0.044715f;
    const float t = x * (c1 + c2 * x * x);
    const float e = __builtin_amdgcn_exp2f(t);
    return x * __builtin_amdgcn_rcpf(1.0f + e);
}

__device__ __forceinline__ float rs_from_slots(const float* slots, int row) {
    const f32x4 v = *(const f32x4*)(slots + (size_t)row * 4);
    return 1.0f / sqrtf(((v[0] + v[1]) + (v[2] + v[3])) * (1.0f / 1024.0f) + RMS_EPS);
}
namespace pg8 {
constexpr int BM = 256, BK = 64, HALF = 128, HTB = HALF * BK * 2  , STAGE_BYTES = 8 * HTB, NXCD = 8, WGM = 8;
__host__ __device__ __forceinline__ int lds_byte(int r, int c) { const int st = (r >> 4) * 2 + (c >> 5), rr = r & 15, cc = c & 31, ob = rr * 64 + cc * 2; return st * 1024 + (ob ^ (((ob >> 9) & 1) << 5)); }
__host__ __device__ __forceinline__ void stage_rc(int b, int& R, int& C) { const int st = b / 1024, sb = b % 1024, swz = sb ^ (((sb >> 9) & 1) << 5); R = (st >> 1) * 16 + swz / 64; C = (st & 1) * 32 + (swz % 64) / 2; }
__host__ __device__ __forceinline__ int perm32(int rho) { const int n = rho >> 4, i = rho & 15; return 8 * (i >> 2) + 4 * n + (i & 3); }

struct Unit { int pm, pn; };
struct Gemm { const bf16_t* A; const bf16_t* Bt; int lda, ldb, K, acol; };

struct StaticOrder {
    int nM, nN, nwg, G, c;
    __host__ __device__ void init(int M_, int N_, int G_, int c_) { nM = M_ / BM; nN = N_ / BM; nwg = nM * nN; G = G_; c = c_; }
    __host__ __device__ bool next(int i, Unit& u) const {
        const long L = (long)i * G + c; if (L >= nwg) return false;
        int wgid = (int)L; { const int q = nwg / NXCD, r = nwg % NXCD, xcd = wgid % NXCD, off = wgid / NXCD; wgid = (xcd < r ? xcd * (q + 1) : r * (q + 1) + (xcd - r) * q) + off; }
        const int nig = WGM * nN, gid = wgid / nig, fm = gid * WGM, gsz = (nM - fm) < WGM ? (nM - fm) : WGM;
        u.pm = fm + ((wgid % nig) % gsz); u.pn = (wgid % nig) / gsz; return true;
    }
    __device__ __forceinline__ void a_ready(const Unit&) const {}
    __device__ __forceinline__ void done(const Unit&) const {}
};

struct RowStats {
    float* xbuf; unsigned* cnt;
    __device__ __forceinline__ void run(const f32x4 (&v)[2][2][4][2], const Unit& u, int wr, int wc, int fr, int fq, LAS unsigned char* xl, int wid, int lane) const {
        LAS float* P = (LAS float*)xl;
        LAS float* S = (LAS float*)(xl + 4096);
#pragma unroll
        for (int ai = 0; ai < 2; ++ai)
#pragma unroll
            for (int m = 0; m < 4; ++m) {
                float q = 0.f;
#pragma unroll
                for (int bj = 0; bj < 2; ++bj)
#pragma unroll
                    for (int n = 0; n < 2; ++n) { const f32x4 d = v[ai][bj][m][n]; q += (d[0] * d[0] + d[1] * d[1]) + (d[2] * d[2] + d[3] * d[3]); }
                q += __shfl_xor(q, 16); q += __shfl_xor(q, 32);
                if (fq == 0) P[(ai * HALF + wr * 64 + m * 16 + fr) * 4 + wc] = q;
            }
        asm volatile("s_waitcnt lgkmcnt(0)" ::: "memory"); __builtin_amdgcn_s_barrier(); asm volatile("" ::: "memory");
        const int row = wid * 32 + (lane & 31);
        if (lane < 32) {
            const float tot = (P[row * 4 + 0] + P[row * 4 + 1]) + (P[row * 4 + 2] + P[row * 4 + 3]);
            __hip_atomic_store(xbuf + ((size_t)(u.pm * BM + row) * 4 + u.pn), tot, __ATOMIC_RELAXED, __HIP_MEMORY_SCOPE_AGENT);
        }
        asm volatile("s_waitcnt vmcnt(0)" ::: "memory");
        if (lane == 0) __hip_atomic_fetch_add(cnt + 64 * u.pm, 1u, __ATOMIC_RELAXED, __HIP_MEMORY_SCOPE_AGENT);
        if (wid == 0) {
            unsigned sp = 0;
            for (;;) {
                if ((unsigned)__builtin_amdgcn_readfirstlane(__hip_atomic_load(cnt + 64 * u.pm, __ATOMIC_RELAXED, __HIP_MEMORY_SCOPE_AGENT)) >= 32u) break;
                if (++sp > (1u << 22)) break;
                __builtin_amdgcn_s_sleep(1);
            }
            __builtin_amdgcn_fence(__ATOMIC_ACQUIRE, "agent");
        }
        asm volatile("s_waitcnt vmcnt(0) lgkmcnt(0)" ::: "memory"); __builtin_amdgcn_s_barrier(); asm volatile("" ::: "memory");
        if (lane < 32) {
            const float* slot = xbuf + (size_t)(u.pm * BM + row) * 4; float q = 0.f;
#pragma unroll
            for (int t = 0; t < 4; ++t) q += __hip_atomic_load(slot + t, __ATOMIC_RELAXED, __HIP_MEMORY_SCOPE_AGENT);
            S[row] = 1.0f / sqrtf(q * (1.0f / 1024.0f) + RMS_EPS);
        }
        asm volatile("s_waitcnt lgkmcnt(0)" ::: "memory"); __builtin_amdgcn_s_barrier(); asm volatile("" ::: "memory");
    }
};
struct EpiResNorm {
    static constexpr bool PERM = false, AFTER_DRAIN = false, APERM = false;
    static __device__ __forceinline__ void partial(const f32x4 (&v)[2][2][4][2], const Unit& u, int wr, int wc, int fr, int fq, LAS unsigned char* xl, int wid, int lane, float* slots) {
        LAS float* P = (LAS float*)xl;
#pragma unroll
        for (int ai = 0; ai < 2; ++ai)
#pragma unroll
            for (int m = 0; m < 4; ++m) {
                float q = 0.f;
#pragma unroll
                for (int bj = 0; bj < 2; ++bj)
#pragma unroll
                    for (int n = 0; n < 2; ++n) { const f32x4 d = v[ai][bj][m][n]; q += (d[0] * d[0] + d[1] * d[1]) + (d[2] * d[2] + d[3] * d[3]); }
                q += __shfl_xor(q, 16); q += __shfl_xor(q, 32);
                if (fq == 0) P[(ai * HALF + wr * 64 + m * 16 + fr) * 4 + wc] = q;
            }
        asm volatile("s_waitcnt lgkmcnt(0)" ::: "memory"); __builtin_amdgcn_s_barrier(); asm volatile("" ::: "memory");
        if (lane < 32) { const int row = wid * 32 + lane; slots[(size_t)(u.pm * BM + row) * 4 + u.pn] = (P[row * 4 + 0] + P[row * 4 + 1]) + (P[row * 4 + 2] + P[row * 4 + 3]); }
    }
    const unsigned short* xsrc; void* xdst; int dst16; bf16_t* xn; const float* g; RowStats st1, st2;
    __device__ __forceinline__ void operator()(f32x4 (&acc)[2][2][4][2], const Unit& u, int wr, int wc, int fr_in, int fq_in, LAS unsigned char* xl) const {
        unsigned ones = ~0u; asm volatile("" : "+s"(ones));
        int lane = __builtin_amdgcn_mbcnt_hi(ones, __builtin_amdgcn_mbcnt_lo(ones, 0u)); asm volatile("" : "+v"(lane));
        const int fr = lane & 15, fq = lane >> 4; (void)fr_in; (void)fq_in;
        const int wid = wr * 4 + wc;
        const LAS float* S = (const LAS float*)(xl + 4096);
        const int col0 = u.pn * BM + wc * 32 + 4 * fq;
        u32x2 pre[2][4][2][2]; f32x4 gv[2][2];
#define RN_LD(ai, m) do { const unsigned off_ = (unsigned)(u.pm * BM + (ai) * HALF + wr * 64 + (m) * 16 + fr) * D + col0; \
            _Pragma("unroll") for (int bj = 0; bj < 2; ++bj) _Pragma("unroll") for (int n = 0; n < 2; ++n) pre[ai][m][bj][n] = *(const u32x2*)(xsrc + off_ + bj * HALF + n * 16); } while (0)
        RN_LD(0, 0); RN_LD(0, 1); RN_LD(0, 2); RN_LD(0, 3); RN_LD(1, 0); RN_LD(1, 1); RN_LD(1, 2); RN_LD(1, 3);
#undef RN_LD
#pragma unroll
        for (int bj = 0; bj < 2; ++bj)
#pragma unroll
            for (int n = 0; n < 2; ++n) gv[bj][n] = *(const f32x4*)(g + col0 + bj * HALF + n * 16);
        st1.run(acc, u, wr, wc, fr, fq, xl, wid, lane);
#pragma unroll
        for (int ai = 0; ai < 2; ++ai)
#pragma unroll
            for (int m = 0; m < 4; ++m) { const int r = ai * HALF + wr * 64 + m * 16 + fr; const float sr = S[r]; const unsigned off = (unsigned)(u.pm * BM + r) * D + col0;
#pragma unroll
                for (int bj = 0; bj < 2; ++bj)
#pragma unroll
                    for (int n = 0; n < 2; ++n) { const u32x2 p = pre[ai][m][bj][n];
                        const f32x4 x1 = (f32x4){h_lo(p.x), h_hi(p.x), h_lo(p.y), h_hi(p.y)} + acc[ai][bj][m][n] * sr * gv[bj][n]; acc[ai][bj][m][n] = x1;
                        if (dst16) { u32x2 w; w.x = pkh2(x1[0], x1[1]); w.y = pkh2(x1[2], x1[3]); *(u32x2*)((unsigned short*)xdst + off + bj * HALF + n * 16) = w; }
                        else *(f32x4*)((float*)xdst + off + bj * HALF + n * 16) = x1; }
                asm volatile("" : "+v"(acc[ai][0][m][0]), "+v"(acc[ai][0][m][1]), "+v"(acc[ai][1][m][0]), "+v"(acc[ai][1][m][1])); }
        if (xn) {
#pragma unroll
            for (int ai = 0; ai < 2; ++ai)
#pragma unroll
                for (int m = 0; m < 4; ++m) { const int r = ai * HALF + wr * 64 + m * 16 + fr; const unsigned off = (unsigned)(u.pm * BM + r) * D + col0;
#pragma unroll
                    for (int bj = 0; bj < 2; ++bj)
#pragma unroll
                        for (int n = 0; n < 2; ++n) { const f32x4 x1 = acc[ai][bj][m][n]; u32x2 w; w.x = pk2(x1[0], x1[1]); w.y = pk2(x1[2], x1[3]); *(u32x2*)(xn + off + bj * HALF + n * 16) = w; } }
            partial(acc, u, wr, wc, fr, fq, xl, wid, lane, st2.xbuf);
        }
    }
};

struct EpiQKV {
    static constexpr bool PERM = true, AFTER_DRAIN = false, APERM = false;
    bf16_t* Q; bf16_t* Kb; bf16_t* Vt; const float* cs; const float* sn; const LAS float* rsl; int pm8;
    __device__ __forceinline__ void operator()(f32x4 (&acc)[2][2][4][2], const Unit& u, int wr, int wc, int fr, int fq, LAS unsigned char*) const {
#pragma unroll
        for (int ai = 0; ai < 2; ++ai)
#pragma unroll
            for (int m = 0; m < 4; ++m) { const float rs = rsl[((u.pm >> 3) - pm8) * 256 + ai * HALF + wr * 64 + m * 16 + fr];
#pragma unroll
                for (int bj = 0; bj < 2; ++bj)
#pragma unroll
                    for (int n = 0; n < 2; ++n) acc[ai][bj][m][n] = acc[ai][bj][m][n] * rs; }
        if (u.pn <= 4) {
            bf16_t* base; int ld, head;
            if (u.pn < 4) { base = Q; ld = D; head = u.pn * 4 + wc; } else { base = Kb; ld = 256; head = wc; }
#pragma unroll
            for (int ai = 0; ai < 2; ++ai)
#pragma unroll
                for (int m = 0; m < 4; ++m) {
                    const int row = u.pm * BM + ai * HALF + wr * 64 + m * 16 + fr;
                    const float* cp = cs + (size_t)row * 32 + 8 * fq; const float* sp = sn + (size_t)row * 32 + 8 * fq;
                    u32x4 w1, w2;
#pragma unroll
                    for (int n = 0; n < 2; ++n) {
                        const f32x4 c = *(const f32x4*)(cp + 4 * n), s = *(const f32x4*)(sp + 4 * n);
                        const f32x4 x1 = acc[ai][0][m][n], x2 = acc[ai][1][m][n];
                        const f32x4 o1 = x1 * c - x2 * s, o2 = x2 * c + x1 * s;
                        if (n == 0) { w1.x = pk2(o1[0], o1[1]); w1.y = pk2(o1[2], o1[3]); w2.x = pk2(o2[0], o2[1]); w2.y = pk2(o2[2], o2[3]); }
                        else        { w1.z = pk2(o1[0], o1[1]); w1.w = pk2(o1[2], o1[3]); w2.z = pk2(o2[0], o2[1]); w2.w = pk2(o2[2], o2[3]); }
                    }
                    bf16_t* op = base + (size_t)row * ld + head * 64 + 8 * fq;
                    *(u32x4*)op = w1; *(u32x4*)(op + 32) = w2;
                }
        } else {
            const int pos = (fr & 3) + 4 * ((fr >> 3) & 1) + 8 * ((fr >> 2) & 1);
#pragma unroll
            for (int ai = 0; ai < 2; ++ai)
#pragma unroll
                for (int m = 0; m < 4; ++m) {
                    const int row = u.pm * BM + ai * HALF + wr * 64 + m * 16;
                    const int b = row >> 12, s = (row & 4095) + pos;
#pragma unroll
                    for (int bj = 0; bj < 2; ++bj)
#pragma unroll
                        for (int n = 0; n < 2; ++n)
#pragma unroll
                            for (int e = 0; e < 4; ++e) {
                                const int c = bj * HALF + wc * 32 + 8 * fq + 4 * n + e, hk = c >> 6, d = c & 63;
                                Vt[((size_t)((b * NKVH + hk) * HD + d)) * SEQ + s] = (bf16_t)(pk2(acc[ai][bj][m][n][e], 0.f) & 0xffffu);
                            }
                }
        }
    }
};

struct EpiGlu {
    static constexpr bool PERM = true, AFTER_DRAIN = false, APERM = true;
    bf16_t* Aout; const float* cw; const float* cb; float* side; const LAS float* rsl; int pm8;
    __device__ __forceinline__ void operator()(f32x4 (&acc)[2][2][4][2], const Unit& u, int wr, int wc, int fr, int fq, LAS unsigned char* xl) const {
        LAS f32x4* X = (LAS f32x4*)xl;
        const int tc0 = wc * 32 + 8 * fq;
        f32x4 W[2][8];
#define GLU_LOADW(n) do { const int c0 = u.pn * 128 + tc0 + 4 * (n); \
            W[n][0] = *(const f32x4*)(cw + c0); W[n][1] = *(const f32x4*)(cw + FF2 + c0); W[n][2] = *(const f32x4*)(cw + 2 * FF2 + c0); W[n][3] = *(const f32x4*)(cb + c0); \
            W[n][4] = *(const f32x4*)(cw + FF + c0); W[n][5] = *(const f32x4*)(cw + FF2 + FF + c0); W[n][6] = *(const f32x4*)(cw + 2 * FF2 + FF + c0); W[n][7] = *(const f32x4*)(cb + FF + c0); } while (0)
        GLU_LOADW(0);
#pragma unroll
        for (int ai = 0; ai < 2; ++ai)
#pragma unroll
            for (int m = 0; m < 4; ++m) { const float rs = rsl[((u.pm >> 3) - pm8) * 256 + ai * HALF + wr * 64 + 4 * fr + m];
#pragma unroll
                for (int bj = 0; bj < 2; ++bj)
#pragma unroll
                    for (int n = 0; n < 2; ++n) acc[ai][bj][m][n] = acc[ai][bj][m][n] * rs; }
        if (fr == 15) {
#pragma unroll
            for (int ai = 0; ai < 2; ++ai)
#pragma unroll
                for (int bj = 0; bj < 2; ++bj)
#pragma unroll
                    for (int n = 0; n < 2; ++n) { X[((ai * 2 + wr) * 2 + 0) * 64 + ((bj * HALF + tc0 + 4 * n) >> 2)] = acc[ai][bj][2][n]; X[((ai * 2 + wr) * 2 + 1) * 64 + ((bj * HALF + tc0 + 4 * n) >> 2)] = acc[ai][bj][3][n]; }
        }
        if (wr == 0 && fr == 0) {
#pragma unroll
            for (int bj = 0; bj < 2; ++bj)
#pragma unroll
                for (int n = 0; n < 2; ++n) { *(f32x4*)(side + ((size_t)(u.pm * 4 + 0)) * FF2 + u.pn * 256 + bj * HALF + tc0 + 4 * n) = acc[0][bj][0][n]; *(f32x4*)(side + ((size_t)(u.pm * 4 + 1)) * FF2 + u.pn * 256 + bj * HALF + tc0 + 4 * n) = acc[0][bj][1][n]; }
        }
        if (wr == 1 && fr == 15) {
#pragma unroll
            for (int bj = 0; bj < 2; ++bj)
#pragma unroll
                for (int n = 0; n < 2; ++n) { *(f32x4*)(side + ((size_t)(u.pm * 4 + 2)) * FF2 + u.pn * 256 + bj * HALF + tc0 + 4 * n) = acc[1][bj][2][n]; *(f32x4*)(side + ((size_t)(u.pm * 4 + 3)) * FF2 + u.pn * 256 + bj * HALF + tc0 + 4 * n) = acc[1][bj][3][n]; }
        }
        asm volatile("s_waitcnt lgkmcnt(0)" ::: "memory"); __builtin_amdgcn_s_barrier(); asm volatile("" ::: "memory");
        const int row0 = u.pm * BM + wr * 64 + 4 * fr;
        const float c1 = -2.0f * 0.7978845608028654f * LOG2E, c2 = c1 * 0.044715f;
#pragma unroll
        for (int n = 0; n < 2; ++n) {
#pragma unroll
            for (int ai = 0; ai < 2; ++ai) {
                if (n == 0 && ai == 1) GLU_LOADW(1);
                const int sidx = ai * 2 + wr;
                f32x4 g2h = (f32x4){0.f, 0.f, 0.f, 0.f}, g3h = g2h, v2h = g2h, v3h = g2h;
                if (sidx > 0) { g2h = X[((sidx - 1) * 2 + 0) * 64 + ((tc0 + 4 * n) >> 2)]; g3h = X[((sidx - 1) * 2 + 1) * 64 + ((tc0 + 4 * n) >> 2)];
                                v2h = X[((sidx - 1) * 2 + 0) * 64 + ((HALF + tc0 + 4 * n) >> 2)]; v3h = X[((sidx - 1) * 2 + 1) * 64 + ((HALF + tc0 + 4 * n) >> 2)]; }
                f32x4 G2, G3, V2, V3;
#pragma unroll
                for (int e = 0; e < 4; ++e) { G2[e] = dppf<DPP_SHR1>(g2h[e], acc[ai][0][2][n][e]); G3[e] = dppf<DPP_SHR1>(g3h[e], acc[ai][0][3][n][e]);
                                              V2[e] = dppf<DPP_SHR1>(v2h[e], acc[ai][1][2][n][e]); V3[e] = dppf<DPP_SHR1>(v3h[e], acc[ai][1][3][n][e]); }
#pragma unroll
                for (int m = 0; m < 4; ++m) {
                    const f32x4 g0 = acc[ai][0][m][n], v0 = acc[ai][1][m][n];
                    const f32x4 g1 = (m == 0) ? G3 : acc[ai][0][m - 1 < 0 ? 0 : m - 1][n], gm2 = (m == 0) ? G2 : (m == 1) ? G3 : acc[ai][0][m - 2 < 0 ? 0 : m - 2][n];
                    const f32x4 v1 = (m == 0) ? V3 : acc[ai][1][m - 1 < 0 ? 0 : m - 1][n], vm2 = (m == 0) ? V2 : (m == 1) ? V3 : acc[ai][1][m - 2 < 0 ? 0 : m - 2][n];
                    const f32x4 cgv = W[n][3] + W[n][2] * g0 + W[n][1] * g1 + W[n][0] * gm2;
                    const f32x4 cvv = W[n][7] + W[n][6] * v0 + W[n][5] * v1 + W[n][4] * vm2;
                    unsigned ow[2];
#pragma unroll
                    for (int h = 0; h < 2; ++h) {
                        const f32x2_t x = {cgv[2 * h], cgv[2 * h + 1]}, y = {cvv[2 * h], cvv[2 * h + 1]};
                        const f32x2_t t = x * (x * x * c2 + c1);
                        f32x2_t d; d.x = __builtin_amdgcn_exp2f(t.x); d.y = __builtin_amdgcn_exp2f(t.y); d = d + 1.0f;
                        f32x2_t r; r.x = __builtin_amdgcn_rcpf(d.x); r.y = __builtin_amdgcn_rcpf(d.y);
                        const f32x2_t o = (x * y) * r;
                        ow[h] = pk2(o.x, o.y);
                    }
                    u32x2 w; w.x = ow[0]; w.y = ow[1];
                    *(u32x2*)(Aout + (size_t)(row0 + ai * HALF + m) * FF + u.pn * 128 + tc0 + 4 * n) = w;
                }
                __builtin_amdgcn_sched_barrier(0);
            }
        }
#undef GLU_LOADW
    }
};

template <class Epi, class Sched, bool ALIGN_EPI = false, bool SP2 = false>
__device__ __forceinline__ void gemm_phase(PG8_LAS unsigned char* lds, const Gemm g, const Sched& S, const Epi& E, const int tid) {
    const int wid = __builtin_amdgcn_readfirstlane(tid >> 6), lane = tid & 63, wr = wid >> 2, wc = wid & 3, fr = lane & 15, fq = lane >> 4;
    const int K = g.K, nt = K / BK;
    unsigned voffA[2], voffB[2];
#pragma unroll
    for (int i = 0; i < 2; ++i) { int R, C; stage_rc(tid * 16 + i * 8192, R, C); const int Rb = Epi::PERM ? ((R & ~31) + perm32(R & 31)) : R;
        const int Ra = Epi::APERM ? ((R & 64) + 4 * (R & 15) + ((R >> 4) & 3)) : R;
        voffA[i] = (unsigned)(Ra * g.lda + C) * 2u; voffB[i] = (unsigned)(Rb * g.ldb + C) * 2u; }
    const size_t kstep = (size_t)(BK * 2);
    const size_t hstepA = (size_t)HALF * g.lda * 2, hstepB = (size_t)HALF * g.ldb * 2;
    const size_t tstepA = 2 * hstepA, tstepB = 2 * hstepB;
    const unsigned ldsw = (unsigned)wid * 1024u;
    const int aoff = lds_byte(wr * 64 + fr, fq * 8), boff = lds_byte(wc * 32 + fr, fq * 8);
#define PG8_SA(b, h) (((b) * 2 + (h)) * HTB)
#define PG8_SB(b, h) ((4 + (b) * 2 + (h)) * HTB)
#define PG8_STAGE(bufoff, gbase, voff) do { _Pragma("unroll") for (int _i = 0; _i < 2; ++_i) \
        __builtin_amdgcn_global_load_lds((const unsigned*)((const char*)(gbase) + (voff)[_i]), (PG8_LAS unsigned*)(lds + (bufoff) + ldsw + _i * 8192), 16, 0, 0); } while (0)
#define PG8_LDA(dst, b, h) do { _Pragma("unroll") for (int m = 0; m < 4; ++m) _Pragma("unroll") for (int k = 0; k < 2; ++k) dst[m][k] = *(const PG8_LAS bf16x8*)(lds + PG8_SA(b, h) + aoff + m * 2048 + k * 1024); } while (0)
#define PG8_LDB(dst, b, h) do { _Pragma("unroll") for (int n = 0; n < 2; ++n) _Pragma("unroll") for (int k = 0; k < 2; ++k) dst[n][k] = *(const PG8_LAS bf16x8*)(lds + PG8_SB(b, h) + boff + n * 2048 + k * 1024); } while (0)
#define PG8_MMA(ai, bj, At, Bt) do { __builtin_amdgcn_s_setprio(1); _Pragma("unroll") for (int m = 0; m < 4; ++m) _Pragma("unroll") for (int n = 0; n < 2; ++n) _Pragma("unroll") for (int k = 0; k < 2; ++k) \
        acc[ai][bj][m][n] = __builtin_amdgcn_mfma_f32_16x16x32_bf16(Bt[n][k], At[m][k], acc[ai][bj][m][n], 0, 0, 0); __builtin_amdgcn_s_setprio(0); } while (0)
#define PG8_WAIT_V(n) asm volatile("s_waitcnt vmcnt(" #n ")" ::: "memory")
#define PG8_WAIT_L(n) asm volatile("s_waitcnt lgkmcnt(" #n ")" ::: "memory")
#define PG8_BAR __builtin_amdgcn_s_barrier()
#define PG8_SCHED __builtin_amdgcn_sched_barrier(0)
    Unit cur, nxt; int ui = 0;
    if (!S.next(0, cur)) return;
    f32x4 acc[2][2][4][2];
#pragma unroll
    for (int a = 0; a < 2; ++a)
#pragma unroll
        for (int b = 0; b < 2; ++b)
#pragma unroll
            for (int m = 0; m < 4; ++m)
#pragma unroll
                for (int n = 0; n < 2; ++n) acc[a][b][m][n] = (f32x4){0.f, 0.f, 0.f, 0.f};
    bf16x8 At[4][2], B0[2][2], B1[2][2];
    const char* cA = (const char*)g.A + (size_t)cur.pm * tstepA + (size_t)cur.pn * g.acol * 2; const char* cB = (const char*)g.Bt + (size_t)cur.pn * tstepB;
    S.a_ready(cur);
    if constexpr (SP2) {
        PG8_STAGE(PG8_SB(0, 0), cB, voffB); PG8_STAGE(PG8_SB(0, 1), cB + hstepB, voffB); PG8_STAGE(PG8_SA(0, 0), cA, voffA); PG8_STAGE(PG8_SA(0, 1), cA + hstepA, voffA);
        if (wr == 1) PG8_BAR;
        PG8_WAIT_V(2); PG8_BAR;
        PG8_STAGE(PG8_SB(1, 0), cB + kstep, voffB); PG8_STAGE(PG8_SA(1, 0), cA + kstep, voffA); PG8_STAGE(PG8_SB(1, 1), cB + hstepB + kstep, voffB);
        PG8_WAIT_V(6); PG8_BAR;
    } else {
        PG8_STAGE(PG8_SB(0, 0), cB, voffB); PG8_STAGE(PG8_SA(0, 0), cA, voffA); PG8_STAGE(PG8_SB(0, 1), cB + hstepB, voffB); PG8_STAGE(PG8_SA(0, 1), cA + hstepA, voffA);
        if (wr == 1) PG8_BAR;
        PG8_WAIT_V(4); PG8_BAR;
        PG8_STAGE(PG8_SB(1, 0), cB + kstep, voffB); PG8_STAGE(PG8_SA(1, 0), cA + kstep, voffA); PG8_STAGE(PG8_SB(1, 1), cB + hstepB + kstep, voffB);
        PG8_WAIT_V(6); PG8_BAR;
    }
    for (;;) {
        const bool has_next = S.next(ui + 1, nxt);
        const char* nA = has_next ? (const char*)g.A + (size_t)nxt.pm * tstepA + (size_t)nxt.pn * g.acol * 2 : cA; const char* nB = has_next ? (const char*)g.Bt + (size_t)nxt.pn * tstepB : cB;
        for (int t = 0; t < nt; t += 2) {
            const bool last = (t == nt - 2);
            const char* a1 = cA + (size_t)(t + 1) * kstep;
            const char* a2 = last ? nA : cA + (size_t)(t + 2) * kstep; const char* b2 = last ? nB : cB + (size_t)(t + 2) * kstep;
            const char* a3 = a2 + kstep; const char* b3 = b2 + kstep;
            if (last && has_next) S.a_ready(nxt);
            if constexpr (SP2) {
            PG8_LDB(B0, 0, 0); PG8_LDB(B1, 0, 1); PG8_SCHED; PG8_LDA(At, 0, 0); PG8_STAGE(PG8_SA(1, 1), a1 + hstepA, voffA);
            PG8_WAIT_V(8); PG8_WAIT_L(0); PG8_BAR; PG8_MMA(0, 0, At, B0); PG8_MMA(0, 1, At, B1); PG8_BAR; PG8_SCHED;
            PG8_LDA(At, 0, 1); PG8_STAGE(PG8_SB(0, 0), b2, voffB); PG8_STAGE(PG8_SB(0, 1), b2 + hstepB, voffB); PG8_STAGE(PG8_SA(0, 0), a2, voffA);
            PG8_WAIT_V(8); PG8_WAIT_L(0); PG8_BAR; PG8_MMA(1, 0, At, B0); PG8_MMA(1, 1, At, B1); PG8_BAR; PG8_SCHED;
            PG8_LDB(B0, 1, 0); PG8_LDB(B1, 1, 1); PG8_SCHED; PG8_LDA(At, 1, 0); PG8_STAGE(PG8_SA(0, 1), a2 + hstepA, voffA);
            PG8_WAIT_V(8); PG8_WAIT_L(0); PG8_BAR; PG8_MMA(0, 0, At, B0); PG8_MMA(0, 1, At, B1); PG8_BAR; PG8_SCHED;
            PG8_LDA(At, 1, 1); PG8_STAGE(PG8_SB(1, 0), b3, voffB); PG8_STAGE(PG8_SB(1, 1), b3 + hstepB, voffB); PG8_STAGE(PG8_SA(1, 0), a3, voffA);
            PG8_WAIT_V(8); PG8_WAIT_L(0); PG8_BAR; PG8_MMA(1, 0, At, B0); PG8_MMA(1, 1, At, B1); PG8_BAR; PG8_SCHED;
            } else {
            PG8_LDB(B0, 0, 0); PG8_SCHED; PG8_LDA(At, 0, 0); PG8_STAGE(PG8_SA(1, 1), a1 + hstepA, voffA);
            PG8_WAIT_L(8); PG8_BAR; PG8_WAIT_L(0); PG8_MMA(0, 0, At, B0); PG8_BAR; PG8_SCHED;
            PG8_LDB(B1, 0, 1); PG8_STAGE(PG8_SB(0, 0), b2, voffB);
            PG8_BAR; PG8_WAIT_L(0); PG8_MMA(0, 1, At, B1); PG8_BAR;
            PG8_LDA(At, 0, 1); PG8_STAGE(PG8_SA(0, 0), a2, voffA);
            PG8_BAR; PG8_WAIT_L(0); PG8_MMA(1, 0, At, B0); PG8_BAR; PG8_SCHED;
            PG8_STAGE(PG8_SB(0, 1), b2 + hstepB, voffB);
            PG8_WAIT_V(6); PG8_BAR; PG8_MMA(1, 1, At, B1); PG8_BAR;
            PG8_LDB(B0, 1, 0); PG8_SCHED; PG8_LDA(At, 1, 0); PG8_STAGE(PG8_SA(0, 1), a2 + hstepA, voffA);
            PG8_WAIT_L(8); PG8_BAR; PG8_WAIT_L(0); PG8_MMA(0, 0, At, B0); PG8_BAR; PG8_SCHED;
            PG8_LDB(B1, 1, 1); PG8_STAGE(PG8_SB(1, 0), b3, voffB);
            PG8_BAR; PG8_WAIT_L(0); PG8_MMA(0, 1, At, B1); PG8_BAR;
            PG8_LDA(At, 1, 1); PG8_STAGE(PG8_SA(1, 0), a3, voffA);
            PG8_BAR; PG8_WAIT_L(0); PG8_MMA(1, 0, At, B0); PG8_BAR; PG8_SCHED;
            PG8_STAGE(PG8_SB(1, 1), b3 + hstepB, voffB);
            PG8_WAIT_V(6); PG8_BAR; PG8_MMA(1, 1, At, B1); PG8_BAR;
            }
        }
        if constexpr (ALIGN_EPI) { if (wr == 0) PG8_BAR; }
        if constexpr (!Epi::AFTER_DRAIN) { E(acc, cur, wr, wc, fr, fq, lds + STAGE_BYTES); S.done(cur); }
        if (!has_next) break;
#pragma unroll
        for (int a = 0; a < 2; ++a)
#pragma unroll
            for (int b = 0; b < 2; ++b)
#pragma unroll
                for (int m = 0; m < 4; ++m)
#pragma unroll
                    for (int n = 0; n < 2; ++n) acc[a][b][m][n] = (f32x4){0.f, 0.f, 0.f, 0.f};
        cur = nxt; cA = nA; cB = nB; ++ui;
        if constexpr (ALIGN_EPI) { if (wr == 1) PG8_BAR; }
    }
    PG8_WAIT_V(0);
    if constexpr (!ALIGN_EPI) { if (wr == 0) PG8_BAR; }
    PG8_BAR;
    if constexpr (Epi::AFTER_DRAIN) { E.fused(acc, cur, wr, wc, fr, fq, lds, wid, lane); S.done(cur); }
#undef PG8_SA
#undef PG8_SB
#undef PG8_STAGE
#undef PG8_LDA
#undef PG8_LDB
#undef PG8_MMA
#undef PG8_WAIT_V
#undef PG8_WAIT_L
#undef PG8_BAR
#undef PG8_SCHED
}
}

constexpr size_t MiB = 1u << 20;
constexpr size_t WS_BT1 = 0;
constexpr size_t WS_BT2 = 44 * MiB;
constexpr size_t WS_BTQKV = 66 * MiB;
constexpr size_t WS_BTO = 71 * MiB;
constexpr size_t WS_BTP = 75 * MiB;
constexpr size_t WS_COS = 76 * MiB, WS_SIN = 80 * MiB;
constexpr size_t WS_SIDE = 84 * MiB;
constexpr size_t WS_XN = 96 * MiB;
constexpr size_t WS_T = 160 * MiB;
constexpr size_t WS_K = 224 * MiB, WS_VT = 240 * MiB;
constexpr size_t WS_A = 256 * MiB;
constexpr size_t WS_CTL = 432 * MiB, CTL_BYTES = 4 * MiB;
constexpr size_t WS_XH = 440 * MiB;
constexpr size_t WS_END = 504 * MiB;
constexpr int CW_SEAM = 16384;

constexpr int LDS_BYTES = 147456;
constexpr int NWAVES = 8;

struct Args {
    const float* x; const int* positions; const float* mix_pre_g; const float* mix_post_g; const float* pool_w; const float* pool_scale;
    const float* kv_norm_g; const float* w_kv; const float* w_q; const float* w_o; const float* sinks; const float* ffn_pre_g; const float* ffn_post_g;
    const float* ffn_w_in; const float* ffn_conv_w; const float* ffn_conv_b; const float* ffn_w_out;
    float* out; unsigned char* ws;
    float inv_freq[32];
    int ph_lo, ph_hi;
};

__device__ __forceinline__ float wave_sum(float v) {
#pragma unroll
    for (int o = 1; o < 64; o <<= 1) v += __shfl_xor(v, o);
    return v;
}

__device__ __forceinline__ void transpose_item(const float* W, int ldw, int k0, int n0, bf16_t* WT, int ldo, int orow0, const float* gk, const float* gn, float cst, LAS float* scr, int lane) {
#pragma unroll 8
    for (int i = 0; i < 32; ++i) { const int kk = 2 * i + (lane >> 5); float v = W[(size_t)(k0 + kk) * ldw + n0 + (lane & 31)]; if (gk) v *= gk[k0 + kk]; scr[kk * 33 + (lane & 31)] = v; }
    asm volatile("s_waitcnt lgkmcnt(0)" ::: "memory");
    const int c = lane & 7;
#pragma unroll
    for (int j = 0; j < 4; ++j) { const int n = (lane >> 3) + 8 * j; const LAS float* s = scr + (8 * c) * 33 + n;
        const float gg = (gn ? gn[n0 + n] : 1.0f) * cst;
        u32x4 o; o.x = pk2(s[0 * 33] * gg, s[1 * 33] * gg); o.y = pk2(s[2 * 33] * gg, s[3 * 33] * gg); o.z = pk2(s[4 * 33] * gg, s[5 * 33] * gg); o.w = pk2(s[6 * 33] * gg, s[7 * 33] * gg);
        *(u32x4*)(WT + (size_t)(orow0 + n) * ldo + k0 + 8 * c) = o; }
    asm volatile("s_waitcnt lgkmcnt(0)" ::: "memory");
}

__device__ __forceinline__ void row_phase(const float* xsrc, const bf16_t* t, const float* g, float* xdst, bf16_t* xn, float* slots, unsigned short* xh, int gw, int NGW, int lane) {
    f32x4 gv[4];
#pragma unroll
    for (int j = 0; j < 4; ++j) gv[j] = g ? *(const f32x4*)(g + 4 * lane + 256 * j) : (f32x4){0.f, 0.f, 0.f, 0.f};
    f32x4 xv[4], xnx[4]; u32x2 tw[4], tnx[4];
    if (gw < M) {
#pragma unroll
        for (int j = 0; j < 4; ++j) { xv[j] = *(const f32x4*)(xsrc + (size_t)gw * D + 4 * lane + 256 * j); tw[j] = t ? *(const u32x2*)(t + (size_t)gw * D + 4 * lane + 256 * j) : (u32x2){0u, 0u}; }
    }
    for (int m = gw; m < M; m += NGW) {
        const int mn = m + NGW;
        if (mn < M) {
#pragma unroll
            for (int j = 0; j < 4; ++j) { xnx[j] = *(const f32x4*)(xsrc + (size_t)mn * D + 4 * lane + 256 * j); tnx[j] = t ? *(const u32x2*)(t + (size_t)mn * D + 4 * lane + 256 * j) : (u32x2){0u, 0u}; }
        }
        if (t) {
            f32x4 tv[4]; float ss = 0.f;
#pragma unroll
            for (int j = 0; j < 4; ++j) { const u32x2 w = tw[j];
                tv[j] = (f32x4){bf_lo(w.x), bf_hi(w.x), bf_lo(w.y), bf_hi(w.y)}; ss += (tv[j][0] * tv[j][0] + tv[j][1] * tv[j][1]) + (tv[j][2] * tv[j][2] + tv[j][3] * tv[j][3]); }
            const float rs = 1.0f / sqrtf(wave_sum(ss) * (1.0f / D) + RMS_EPS);
#pragma unroll
            for (int j = 0; j < 4; ++j) xv[j] += tv[j] * rs * gv[j];
        }
        if (xdst) {
#pragma unroll
            for (int j = 0; j < 4; ++j) *(f32x4*)(xdst + (size_t)m * D + 4 * lane + 256 * j) = xv[j];
        }
        if (xn) {
            float s2 = 0.f;
#pragma unroll
            for (int j = 0; j < 4; ++j) s2 += (xv[j][0] * xv[j][0] + xv[j][1] * xv[j][1]) + (xv[j][2] * xv[j][2] + xv[j][3] * xv[j][3]);
            const float wave_sum_s2 = wave_sum(s2);
#pragma unroll
            for (int j = 0; j < 4; ++j) { u32x2 w; w.x = pk2(xv[j][0], xv[j][1]); w.y = pk2(xv[j][2], xv[j][3]); *(u32x2*)(xn + (size_t)m * D + 4 * lane + 256 * j) = w; }
#pragma unroll
            for (int j = 0; j < 4; ++j) { u32x2 w; w.x = pkh2(xv[j][0], xv[j][1]); w.y = pkh2(xv[j][2], xv[j][3]); *(u32x2*)(xh + (size_t)m * D + 4 * lane + 256 * j) = w; }
            if (lane == 0) *(f32x4*)(slots + (size_t)m * 4) = (f32x4){wave_sum_s2, 0.f, 0.f, 0.f};
        }
#pragma unroll
        for (int j = 0; j < 4; ++j) { xv[j] = xnx[j]; tw[j] = tnx[j]; }
    }
}

__device__ __forceinline__ void add8(float (&a)[8], const u32x4 v, float sgn) {
    a[0] += sgn * bf_lo(v.x); a[1] += sgn * bf_hi(v.x); a[2] += sgn * bf_lo(v.y); a[3] += sgn * bf_hi(v.y); a[4] += sgn * bf_lo(v.z); a[5] += sgn * bf_hi(v.z); a[6] += sgn * bf_lo(v.w); a[7] += sgn * bf_hi(v.w);
}
__device__ __forceinline__ void diff_phase(const bf16_t* xn, const float* slots, bf16_t* dd, int gtid, int NT) {
    for (int item = gtid; item < (M / 32) * 128; item += NT) {
        const int c = item & 127, t0 = (item >> 7) * 32, ts0 = t0 & (SEQ - 1), grp = c >> 5, w = 2 << grp;
        const bf16_t* base = xn + (size_t)t0 * D + 8 * c;
        float S[8] = {0.f, 0.f, 0.f, 0.f, 0.f, 0.f, 0.f, 0.f};
#pragma unroll
        for (int k = 1; k < 16; ++k) { if (k < w && ts0 - k >= 0) add8(S, *(const u32x4*)(base - (size_t)k * D), rs_from_slots(slots, t0 - k)); }
#pragma unroll 1
        for (int i0 = 0; i0 < 32; i0 += 8) {
            u32x4 cur[8], old[8];
#pragma unroll
            for (int i = 0; i < 8; ++i) { cur[i] = *(const u32x4*)(base + (size_t)(i0 + i) * D);
                old[i] = (i0 + i > 0 && ts0 + i0 + i - w >= 0) ? *(const u32x4*)(base + (size_t)(i0 + i - w) * D) : (u32x4){0u, 0u, 0u, 0u}; }
#pragma unroll
            for (int i = 0; i < 8; ++i) {
                const int ts = ts0 + i0 + i;
                if (i0 + i > 0 && ts - w >= 0) add8(S, old[i], -rs_from_slots(slots, t0 + i0 + i - w));
                const float rc = rs_from_slots(slots, t0 + i0 + i);
                add8(S, cur[i], rc);
                const float ic = 1.0f / (float)((ts + 1) < w ? (ts + 1) : w);
                const u32x4 v = cur[i];
                u32x4 o; o.x = pk2(S[0] * ic - rc * bf_lo(v.x), S[1] * ic - rc * bf_hi(v.x)); o.y = pk2(S[2] * ic - rc * bf_lo(v.y), S[3] * ic - rc * bf_hi(v.y));
                o.z = pk2(S[4] * ic - rc * bf_lo(v.z), S[5] * ic - rc * bf_hi(v.z)); o.w = pk2(S[6] * ic - rc * bf_lo(v.w), S[7] * ic - rc * bf_hi(v.w));
                *(u32x4*)(dd + (size_t)(t0 + i0 + i) * D + 8 * c) = o;
            }
        }
    }
}

__device__ __forceinline__ void fixup_phase(const float* side, const float* cw, const float* cb, bf16_t* Aout, int gtid, int NT) {
    for (int idx = gtid; idx < 128 * 2 * (FF / 4); idx += NT) {
        const int c = 4 * (idx % (FF / 4)), i = (idx / (FF / 4)) & 1, pm = idx / (2 * (FF / 4));
        const int sc = (c >> 7) * 256 + (c & 127);
        const f32x4 z = (f32x4){0.f, 0.f, 0.f, 0.f};
        const bool first = (pm & 15) == 0;
        const float* sp = side + (size_t)pm * 4 * FF2 + sc; const float* pp = sp - 4 * FF2;
        f32x4 o;
        {
            const f32x4 gm2 = first ? z : *(const f32x4*)(pp + 2 * FF2), gm1 = first ? z : *(const f32x4*)(pp + 3 * FF2), g0 = *(const f32x4*)(sp), g1 = *(const f32x4*)(sp + FF2);
            const f32x4 vm2 = first ? z : *(const f32x4*)(pp + 2 * FF2 + 128), vm1 = first ? z : *(const f32x4*)(pp + 3 * FF2 + 128), v0 = *(const f32x4*)(sp + 128), v1 = *(const f32x4*)(sp + FF2 + 128);
            const f32x4 wg0 = *(const f32x4*)(cw + c), wg1 = *(const f32x4*)(cw + FF2 + c), wg2 = *(const f32x4*)(cw + 2 * FF2 + c), bg = *(const f32x4*)(cb + c);
            const f32x4 wv0 = *(const f32x4*)(cw + FF + c), wv1 = *(const f32x4*)(cw + FF2 + FF + c), wv2 = *(const f32x4*)(cw + 2 * FF2 + FF + c), bv = *(const f32x4*)(cb + FF + c);
            const f32x4 cgv = (i == 0) ? (wg2 * g0 + wg1 * gm1 + wg0 * gm2 + bg) : (wg2 * g1 + wg1 * g0 + wg0 * gm1 + bg);
            const f32x4 cvv = (i == 0) ? (wv2 * v0 + wv1 * vm1 + wv0 * vm2 + bv) : (wv2 * v1 + wv1 * v0 + wv0 * vm1 + bv);
#pragma unroll
            for (int e = 0; e < 4; ++e) o[e] = gelu_tanh(cgv[e]) * cvv[e];
        }
        u32x2 w; w.x = pk2(o[0], o[1]); w.y = pk2(o[2], o[3]);
        *(u32x2*)(Aout + (size_t)(pm * 256 + i) * FF + c) = w;
    }
}

constexpr int AT_KROW = 144, AT_VROW = 528, AT_VOFF = 256 * AT_KROW;
__device__ __forceinline__ void attn_phase(LAS unsigned char* lds, const bf16_t* Q, const bf16_t* Kb, const bf16_t* Vt, bf16_t* O, const float* sinks, int blk, int G, int wave, int lane, int tid) {
    const int q = lane & 31, hi = lane >> 5;
    const int NU = BATCH * NKVH * 32, UPB = (NU + G - 1) / G;
    u32x4 kr[4], vr[4];
#define AT_LOAD(u_) do { const int b_ = (u_) >> 7, hk_ = ((u_) >> 5) & 3, nb_ = (u_) & 31; \
        int kp_ = nb_ * 128 - 128 + (tid >> 1); if (kp_ < 0) kp_ += 128; \
        int vp_ = nb_ * 128 - 128 + (tid & 7) * 32; if (vp_ < 0) vp_ += 128; \
        const bf16_t* ks_ = Kb + (size_t)(b_ * SEQ + kp_) * 256 + hk_ * 64 + (tid & 1) * 32; \
        const bf16_t* vs_ = Vt + ((size_t)((b_ * NKVH + hk_) * HD + (tid >> 3))) * SEQ + vp_; \
        _Pragma("unroll") for (int j_ = 0; j_ < 4; ++j_) { kr[j_] = *(const u32x4*)(ks_ + j_ * 8); vr[j_] = *(const u32x4*)(vs_ + j_ * 8); } } while (0)
    for (int i = 0; i < UPB; ++i) {
        const int u = blk * UPB + i; if (u >= NU) break;
        const int b = u >> 7, hk = (u >> 5) & 3, nb = u & 31;
        if (i == 0) AT_LOAD(u);
        __syncthreads();
#pragma unroll
        for (int j = 0; j < 4; ++j) { *(LAS u32x4*)(lds + (tid >> 1) * AT_KROW + (tid & 1) * 64 + j * 16) = kr[j]; *(LAS u32x4*)(lds + AT_VOFF + (tid >> 3) * AT_VROW + (tid & 7) * 64 + j * 16) = vr[j]; }
        __syncthreads();
        if (i + 1 < UPB && u + 1 < NU) AT_LOAD(u + 1);
        const int gq = wave >> 1, hq = hk * 4 + gq;
        const float sink2 = sinks[hq] * LOG2E;
#pragma unroll 1
        for (int t = 0; t < 2; ++t) {
            const int sb = 2 * (wave & 1) + t;
            const int row0 = b * SEQ + nb * 128 + sb * 32;
            bf16x8 qf[4];
            { const bf16_t* qp = Q + (size_t)(row0 + q) * D + hq * 64 + hi * 8;
#pragma unroll
              for (int s = 0; s < 4; ++s) qf[s] = *(const bf16x8*)(qp + s * 16); }
            f32x16 st[5];
            const LAS unsigned char* kl = lds + (32 * sb + q) * AT_KROW + hi * 16;
#pragma unroll
            for (int kbi = 0; kbi < 5; ++kbi) {
                f32x16 a = {};
#pragma unroll
                for (int s = 0; s < 4; ++s) { const bf16x8 kf = *(const LAS bf16x8*)(kl + kbi * 32 * AT_KROW + s * 32); a = __builtin_amdgcn_mfma_f32_32x32x16_bf16(kf, qf[s], a, 0, 0, 0); }
                st[kbi] = a;
            }
            const float NEG = -1e30f;
#pragma unroll
            for (int kbi = 0; kbi < 5; ++kbi) {
                const bool dead = (nb == 0) && (sb + kbi < 4);
#pragma unroll
                for (int r = 0; r < 16; ++r) {
                    const int kk = (r & 3) + 8 * (r >> 2) + 4 * hi;
                    bool ok = !dead;
                    if (kbi == 0) ok = ok && (kk > q);
                    if (kbi == 4) ok = ok && (kk <= q);
                    st[kbi][r] = ok ? st[kbi][r] : NEG;
                }
            }
            float mx = sink2;
#pragma unroll
            for (int kbi = 0; kbi < 5; ++kbi)
#pragma unroll
                for (int r = 0; r < 16; ++r) mx = fmaxf(mx, st[kbi][r]);
            mx = fmaxf(mx, __shfl_xor(mx, 32));
            float sum = 0.f;
            bf16x8 pw[5][2];
#pragma unroll
            for (int kbi = 0; kbi < 5; ++kbi) {
                float p[16];
#pragma unroll
                for (int r = 0; r < 16; ++r) { p[r] = __builtin_amdgcn_exp2f(st[kbi][r] - mx); sum += p[r]; }
#pragma unroll
                for (int h = 0; h < 2; ++h) { u32x4 w; w.x = pk2(p[8 * h + 0], p[8 * h + 1]); w.y = pk2(p[8 * h + 2], p[8 * h + 3]); w.z = pk2(p[8 * h + 4], p[8 * h + 5]); w.w = pk2(p[8 * h + 6], p[8 * h + 7]);
                    pw[kbi][h] = __builtin_bit_cast(bf16x8, w); }
            }
            sum += __shfl_xor(sum, 32);
            const float inv = 1.0f / (sum + __builtin_amdgcn_exp2f(sink2 - mx));
            f32x16 ot[2]; ot[0] = f32x16{}; ot[1] = f32x16{};
            const LAS unsigned char* vl = lds + AT_VOFF + q * AT_VROW + (32 * sb + hi * 8) * 2;
#pragma unroll
            for (int kbi = 0; kbi < 5; ++kbi)
#pragma unroll
                for (int h = 0; h < 2; ++h)
#pragma unroll
                    for (int dh = 0; dh < 2; ++dh) {
                        const bf16x8 vf = *(const LAS bf16x8*)(vl + dh * 32 * AT_VROW + (kbi * 32 + h * 16) * 2);
                        ot[dh] = __builtin_amdgcn_mfma_f32_32x32x16_bf16(vf, pw[kbi][h], ot[dh], 0, 0, 0);
                    }
            bf16_t* op = O + (size_t)(row0 + q) * D + hq * 64 + 4 * hi;
#pragma unroll
            for (int dh = 0; dh < 2; ++dh)
#pragma unroll
                for (int rg = 0; rg < 4; ++rg) { u32x2 w; w.x = pk2(ot[dh][4 * rg + 0] * inv, ot[dh][4 * rg + 1] * inv); w.y = pk2(ot[dh][4 * rg + 2] * inv, ot[dh][4 * rg + 3] * inv);
                    *(u32x2*)(op + dh * 32 + 8 * rg) = w; }
        }
    }
#undef AT_LOAD
    __syncthreads();
}

#define XB_TMO      128
#define XB_XCNT(j)  (256  + 64 * (j))
#define XB_XSUB(j)  (1280 + 64 * (j))
#define XB_XGEN(j)  (2304 + 64 * (j))
#define XB_TOP      3328
#define XB_TOPGEN   3392
#define XCD_BAR_WORDS 3456
#define XB_SPIN_CAP (1u << 18)

__device__ __forceinline__ unsigned xb_ld(unsigned* p)              { return __hip_atomic_load(p, __ATOMIC_RELAXED, __HIP_MEMORY_SCOPE_AGENT); }
__device__ __forceinline__ unsigned xb_add(unsigned* p, unsigned v) { return __hip_atomic_fetch_add(p, v, __ATOMIC_RELAXED, __HIP_MEMORY_SCOPE_AGENT); }
__device__ __forceinline__ unsigned xb_xcc_id() { return (unsigned)__builtin_amdgcn_s_getreg((3 << 11) | 20) & 0xFu; }
#define XB_SPIN(cond, bar) do { unsigned _sp = 0; while (cond) { __builtin_amdgcn_s_sleep(1); \
    if ((++_sp & 255u) == 0u) { if (xb_ld(&(bar)[XB_TMO])) break; if (_sp > XB_SPIN_CAP) { atomicAdd(&(bar)[XB_TMO], 1u); break; } } } } while (0)

struct XcdBarrier {
    unsigned* bar; unsigned x;
    volatile LAS unsigned* st;
};

__device__ __forceinline__ XcdBarrier xcd_barrier_post(unsigned* bar, volatile LAS unsigned* st) {
    XcdBarrier b; b.bar = bar; b.x = xb_xcc_id(); b.st = st;
    if (threadIdx.x == 0) (void)xb_add(&bar[XB_XCNT(b.x)], 1u);
    return b;
}
__device__ __forceinline__ void xcd_barrier_complete(unsigned* bar, unsigned x, unsigned& nloc, unsigned& nx) {
    const unsigned G = gridDim.x * gridDim.y * gridDim.z;
    unsigned sum, cnt, mine, sp = 0u;
    for (;;) {
        sum = 0u; cnt = 0u; mine = 0u;
#pragma unroll
        for (unsigned j = 0; j < 16; ++j) { const unsigned c = xb_ld(&bar[XB_XCNT(j)]); sum += c; cnt += (c > 0u) ? 1u : 0u; mine = (j == x) ? c : mine; }
        if (sum == G) break;
        __builtin_amdgcn_s_sleep(1);
        if ((++sp & 255u) == 0u) { if (xb_ld(&bar[XB_TMO])) break; if (sp > XB_SPIN_CAP) { atomicAdd(&bar[XB_TMO], 1u); break; } }
    }
    nloc = mine > 0u ? mine : 1u; nx = cnt > 0u ? cnt : 1u;
}

__device__ __forceinline__ void xcd_barrier(const XcdBarrier& b) {
    asm volatile("s_waitcnt vmcnt(0)" ::: "memory");
    __syncthreads();
    if (threadIdx.x == 0) {
        unsigned* bar = b.bar;
        __builtin_amdgcn_s_waitcnt(0);
        unsigned nloc = b.st[0], nx = b.st[1];
        if (nloc == 0u) { xcd_barrier_complete(bar, b.x, nloc, nx); b.st[0] = nloc; b.st[1] = nx; }
        const unsigned old = xb_add(&bar[XB_XSUB(b.x)], 1u);
        const unsigned gen = old / nloc;
        if (old + 1u == (gen + 1u) * nloc) {
            __builtin_amdgcn_fence(__ATOMIC_RELEASE, "agent");
            asm volatile("s_waitcnt vmcnt(0)" ::: "memory");
            const unsigned og = xb_add(&bar[XB_TOP], 1u);
            const unsigned tg = og / nx;
            if (og + 1u == (tg + 1u) * nx) xb_add(&bar[XB_TOPGEN], 1u);
            else XB_SPIN(xb_ld(&bar[XB_TOPGEN]) == tg, bar);
            __builtin_amdgcn_fence(__ATOMIC_ACQUIRE, "agent");
            xb_add(&bar[XB_XGEN(b.x)], 1u);
            asm volatile("s_waitcnt vmcnt(0)" ::: "memory");
        } else {
            XB_SPIN(xb_ld(&bar[XB_XGEN(b.x)]) == gen, bar);
            __builtin_amdgcn_fence(__ATOMIC_ACQUIRE, "agent");
            asm volatile("s_waitcnt vmcnt(0)" ::: "memory");
        }
    }
    __syncthreads();
}

enum { T_PRO = 0, T_ROWA, T_DIFF, T_POOLG, T_ROWB, T_QKV, T_ATTN, T_WO, T_GLU, T_FIX, T_DOWN };
constexpr int NPH = 23;
__host__ __device__ __forceinline__ void decode_phase(int ph, int& type, int& layer) {
    if (ph == 0) { type = T_PRO; layer = 0; return; }
    if (ph <= 10) { const int k = (ph - 1) % 5; layer = (ph - 1) / 5; type = (int)((0xA9832ull >> (4 * k)) & 15); return; }
    const int k = (ph - 11) % 6; layer = 2 + (ph - 11) / 6; type = (int)((0xA98765ull >> (4 * k)) & 15);
}
#ifndef PH_MASK
#define PH_MASK 0xFFFF
#endif
#define PH_ON(t) (((PH_MASK) >> (t)) & 1)
#define RS_TABLE() LAS float* rsl = (LAS float*)(lds + pg8::STAGE_BYTES + 8192 + 256); int pm8 = 0; \
    { pg8::Unit u0; if (S.next(0, u0)) { pm8 = u0.pm >> 3; const float* sl_ = (const float*)(ws + WS_T) + (size_t)M * 4; \
        for (int e_ = tid; e_ < 768; e_ += NWAVES * 64) { const int pmv = u0.pm + 8 * (e_ >> 8); if (pmv < M / 256) rsl[e_] = rs_from_slots(sl_, pmv * 256 + (e_ & 255)); } } \
      __syncthreads(); }
template <bool COOP>
__global__ void __launch_bounds__(NWAVES * 64, 2) yoco_fwd(Args a) {
    extern __shared__ __attribute__((aligned(16))) unsigned char lds_raw[];
    LAS unsigned char* lds = (LAS unsigned char*)lds_raw;
    const int G = gridDim.x, blk = blockIdx.x;
    const int wave_s = __builtin_amdgcn_readfirstlane(threadIdx.x >> 6);
    volatile LAS unsigned* MISC = (volatile LAS unsigned*)(lds + pg8::STAGE_BYTES + 8192);
    if (threadIdx.x < 16) MISC[threadIdx.x] = 0u;
    __syncthreads();
    XcdBarrier xbar; xbar.bar = (unsigned*)(a.ws + WS_CTL); xbar.x = 0; xbar.st = nullptr;
    if constexpr (COOP) xbar = xcd_barrier_post((unsigned*)(a.ws + WS_CTL), MISC + 8);
    int ph0 = a.ph_lo;
    if (PH_ON(T_PRO) && ph0 == 0) {
        int lane = __builtin_amdgcn_mbcnt_hi(~0u, __builtin_amdgcn_mbcnt_lo(~0u, 0u)); asm volatile("" : "+v"(lane));
        const int wave = wave_s, tid = wave * 64 + lane;
        const int gw = blk * NWAVES + wave, NGW = G * NWAVES;
        unsigned char* ws = a.ws; asm volatile("" : "+s"(ws));
        bf16_t* BT1 = (bf16_t*)(ws + WS_BT1); bf16_t* BT2 = (bf16_t*)(ws + WS_BT2); bf16_t* BTQKV = (bf16_t*)(ws + WS_BTQKV); bf16_t* BTO = (bf16_t*)(ws + WS_BTO); bf16_t* BTP = (bf16_t*)(ws + WS_BTP);
        float* COSB = (float*)(ws + WS_COS); float* SINB = (float*)(ws + WS_SIN); bf16_t* XN = (bf16_t*)(ws + WS_XN);
        {
            LAS float* scr = (LAS float*)(lds + wave * 16384);
            constexpr int I_IN = 16 * 176, I_OUT = 44 * 32, I_Q = 16 * 32, I_KV = 16 * 16, I_O = 16 * 32, I_P = 4 * 8;
            constexpr int NITEMS = 4 * I_IN + 4 * I_OUT + 2 * I_Q + I_KV + 2 * I_O + 8 * I_P;
            for (int it = gw; it < NITEMS; it += NGW) {
                int r = it;
                if (r < 4 * I_IN) { const int l = r / I_IN; r %= I_IN; const int kb = r / 176, nbk = r % 176, n0 = nbk * 32;
                    const int bj = n0 / FF, rem = n0 % FF, pn = rem / 128, j = rem % 128;
                    transpose_item(a.ffn_w_in + (size_t)l * D * FF2, FF2, kb * 64, n0, BT1 + (size_t)l * FF2 * D, D, pn * 256 + bj * 128 + j, a.ffn_pre_g + l * D, nullptr, 1.0f, scr, lane); continue; }
                r -= 4 * I_IN;
                if (r < 4 * I_OUT) { const int l = r / I_OUT; r %= I_OUT; const int kb = r / 32, nbk = r % 32;
                    transpose_item(a.ffn_w_out + (size_t)l * FF * D, D, kb * 64, nbk * 32, BT2 + (size_t)l * D * FF, FF, nbk * 32, nullptr, nullptr, 1.0f, scr, lane); continue; }
                r -= 4 * I_OUT;
                if (r < 2 * I_Q) { const int j2 = r / I_Q; r %= I_Q; const int kb = r / 32, nbk = r % 32, n0 = nbk * 32;
                    const int head = n0 >> 6, half = (n0 >> 5) & 1;
                    transpose_item(a.w_q + (size_t)j2 * D * D, D, kb * 64, n0, BTQKV + (size_t)j2 * NQKV * D, D, (head >> 2) * 256 + half * 128 + (head & 3) * 32, a.mix_pre_g + (2 + j2) * D, nullptr, 0.125f * LOG2E, scr, lane); continue; }
                r -= 2 * I_Q;
                if (r < I_KV) { const int kb = r / 16, nbk = r % 16, n0 = nbk * 32;
                    int orow; if (n0 < 256) { const int head = n0 >> 6, half = (n0 >> 5) & 1; orow = 1024 + half * 128 + head * 32; } else orow = 1280 + (n0 - 256);
                    transpose_item(a.w_kv, 512, kb * 64, n0, BTQKV, D, orow, a.kv_norm_g, nullptr, 1.0f, scr, lane); continue; }
                r -= I_KV;
                if (r < 2 * I_O) { const int j2 = r / I_O; r %= I_O; const int kb = r / 32, nbk = r % 32;
                    transpose_item(a.w_o + (size_t)j2 * D * D, D, kb * 64, nbk * 32, BTO + (size_t)j2 * D * D, D, nbk * 32, nullptr, nullptr, 1.0f, scr, lane); continue; }
                r -= 2 * I_O;
                { const int lg = r / I_P; r %= I_P; const int l = lg >> 2, grp = lg & 3, kb = r / 8, nbk = r % 8;
                    transpose_item(a.pool_w + (size_t)lg * 256 * 256, 256, kb * 64, nbk * 32, BTP + (size_t)l * D * 256, 256, grp * 256 + nbk * 32, a.mix_pre_g + l * D + grp * 256, a.pool_scale + l * D + grp * 256, 1.0f, scr, lane); }
            }
            for (int idx = blk * (NWAVES * 64) + tid; idx < M * 32; idx += G * NWAVES * 64) {
                const int row = idx >> 5, i = idx & 31;
                const float ang = (float)a.positions[row] * a.inv_freq[i];
                const double ad = (double)ang; const double kq = rint(ad * 0.63661977236758134308); const double rr = ad - kq * 1.57079632679489661923;
                const double r2 = rr * rr;
                const double sv = rr * (1.0 + r2 * (-1.0 / 6 + r2 * (1.0 / 120 + r2 * (-1.0 / 5040 + r2 * (1.0 / 362880 + r2 * (-1.0 / 39916800 + r2 * (1.0 / 6227020800.0)))))));
                const double cv = 1.0 + r2 * (-0.5 + r2 * (1.0 / 24 + r2 * (-1.0 / 720 + r2 * (1.0 / 40320 + r2 * (-1.0 / 3628800 + r2 * (1.0 / 479001600.0 + r2 * (-1.0 / 87178291200.0)))))));
                const int qd = ((int)kq) & 3;
                const double c = (qd == 0) ? cv : (qd == 1) ? -sv : (qd == 2) ? -cv : sv;
                const double s = (qd == 0) ? sv : (qd == 1) ? cv : (qd == 2) ? -sv : -cv;
                COSB[idx] = (float)c; SINB[idx] = (float)s;
            }
            row_phase(a.x, nullptr, nullptr, nullptr, XN, (float*)(ws + WS_T) + (size_t)M * 4, (unsigned short*)(ws + WS_XH), gw, NGW, lane);
        }
        ph0 = 1;
        if (ph0 < a.ph_hi) { if constexpr (COOP) { cg::this_grid().sync(); } }
    }
    int rep = 0; (void)rep;
    for (int ph = ph0 < 1 ? 1 : ph0; ph < a.ph_hi; ++ph) {
        int type, layer; decode_phase(ph, type, layer);
        unsigned ones = ~0u; asm volatile("" : "+s"(ones));
        int lane = __builtin_amdgcn_mbcnt_hi(ones, __builtin_amdgcn_mbcnt_lo(ones, 0u)); asm volatile("" : "+v"(lane));
        const int wave = wave_s, tid = wave * 64 + lane;
        const int gw = blk * NWAVES + wave, NGW = G * NWAVES;
        unsigned char* ws = a.ws; asm volatile("" : "+s"(ws));
        bf16_t* BT1 = (bf16_t*)(ws + WS_BT1); bf16_t* BT2 = (bf16_t*)(ws + WS_BT2); bf16_t* BTQKV = (bf16_t*)(ws + WS_BTQKV); bf16_t* BTO = (bf16_t*)(ws + WS_BTO); bf16_t* BTP = (bf16_t*)(ws + WS_BTP);
        float* COSB = (float*)(ws + WS_COS); float* SINB = (float*)(ws + WS_SIN); float* SIDE = (float*)(ws + WS_SIDE);
        bf16_t* XN = (bf16_t*)(ws + WS_XN); bf16_t* TB = (bf16_t*)(ws + WS_T); bf16_t* KB = (bf16_t*)(ws + WS_K); bf16_t* VT = (bf16_t*)(ws + WS_VT);
        bf16_t* AB = (bf16_t*)(ws + WS_A); bf16_t* DB = AB; bf16_t* QO = AB; bf16_t* OB = AB + (size_t)M * D;
        if (false) {
        } else if (PH_ON(T_DIFF) && type == T_DIFF) {
            diff_phase(XN, (const float*)(ws + WS_T) + (size_t)M * 4, DB, blk * (NWAVES * 64) + tid, G * NWAVES * 64);
        } else if (PH_ON(T_FIX) && type == T_FIX) {
            fixup_phase(SIDE, a.ffn_conv_w + (size_t)layer * 3 * FF2, a.ffn_conv_b + (size_t)layer * FF2, AB, blk * (NWAVES * 64) + tid, G * NWAVES * 64);
        } else if (PH_ON(T_ATTN) && type == T_ATTN) {
            attn_phase(lds, QO, KB, VT, OB, a.sinks + (layer - 2) * NQH, blk, G, wave, lane, tid);
        } else if (PH_ON(T_GLU) && type == T_GLU) {
            pg8::Gemm g{XN, BT1 + (size_t)layer * FF2 * D, D, D, D, 0}; pg8::StaticOrder S; S.init(M, FF2, G, blk);
            RS_TABLE();
            pg8::EpiGlu E{AB, a.ffn_conv_w + (size_t)layer * 3 * FF2, a.ffn_conv_b + (size_t)layer * FF2, SIDE, rsl, pm8};
            pg8::gemm_phase<pg8::EpiGlu, pg8::StaticOrder, true, true>(lds, g, S, E, tid);
        } else if (PH_ON(T_QKV) && type == T_QKV) {
            pg8::Gemm g{XN, BTQKV + (size_t)(layer - 2) * NQKV * D, D, D, D, 0}; pg8::StaticOrder S; S.init(M, layer == 2 ? NQKV : D, G, blk);
            RS_TABLE();
            pg8::EpiQKV E{QO, KB, VT, COSB, SINB, rsl, pm8};
            pg8::gemm_phase<pg8::EpiQKV, pg8::StaticOrder, true, true>(lds, g, S, E, tid);
        } else if (PH_ON(T_DOWN)) {
            pg8::Gemm g; const float* gain; void* xd = (void*)(ws + WS_XH); int d16 = 1; bf16_t* xno = XN;
            if (type == T_POOLG) { g = pg8::Gemm{DB, BTP + (size_t)layer * D * 256, D, 256, 256, 256}; gain = a.mix_post_g + layer * D; }
            else if (type == T_WO) { g = pg8::Gemm{OB, BTO + (size_t)(layer - 2) * D * D, D, D, D, 0}; gain = a.mix_post_g + layer * D; }
            else { g = pg8::Gemm{AB, BT2 + (size_t)layer * D * FF, FF, FF, FF, 0}; gain = a.ffn_post_g + layer * D; if (layer == DEPTH - 1) { xno = nullptr; xd = (void*)a.out; d16 = 0; } }
            pg8::StaticOrder S; S.init(M, D, G, blk);
            unsigned* ctl = (unsigned*)(ws + WS_CTL);
            int bank = 2 * ph;
#if defined(PROBE_DUP)
            if ((((PROBE_DUP) >> type) & 1) && rep == 0) { gain = (const float*)(ws + WS_CTL + 3584 * 1024); bank += 46; }
#endif
            pg8::RowStats st1{(float*)(ws + WS_T), ctl + CW_SEAM + bank * 8192}, st2{(float*)(ws + WS_T) + (size_t)M * 4, ctl + CW_SEAM + (bank + 1) * 8192};
            pg8::EpiResNorm E{(const unsigned short*)(ws + WS_XH), xd, d16, xno, gain, st1, st2};
            pg8::gemm_phase<pg8::EpiResNorm, pg8::StaticOrder, true, true>(lds, g, S, E, tid);
        }
        if (ph + 1 < a.ph_hi) {
            if constexpr (COOP) { xcd_barrier(xbar); }
        }
#if defined(PROBE_DUP)
        if ((((PROBE_DUP) >> type) & 1) && rep == 0) { rep = 1; --ph; } else rep = 0;
#endif
    }
}

extern "C" void kernel_launch(void* const* d_in, const int* in_sizes, int n_in, void* d_out, int out_size, void* d_ws, size_t ws_size, hipStream_t stream) {
    static int grid = 0;
    static float invf[32];
    if (grid == 0) {
        if (n_in != 17 || out_size != M * D || ws_size < WS_END) { fprintf(stderr, "kernel_launch: unexpected shapes (n_in %d, out %d, ws %zu)\n", n_in, out_size, ws_size); grid = -1; return; }
        int dev = 0, cus = 0, per_cu = 0;
        (void)hipGetDevice(&dev); (void)hipDeviceGetAttribute(&cus, hipDeviceAttributeMultiprocessorCount, dev);
#if defined(MK_PER_PHASE)
        const void* kfn = (const void*)yoco_fwd<false>;
#else
        const void* kfn = (const void*)yoco_fwd<true>;
#endif
        (void)hipFuncSetAttribute(kfn, hipFuncAttributeMaxDynamicSharedMemorySize, LDS_BYTES);
        (void)hipOccupancyMaxActiveBlocksPerMultiprocessor(&per_cu, kfn, NWAVES * 64, LDS_BYTES);
        if (per_cu < 1) { fprintf(stderr, "kernel_launch: occupancy query says %d blocks per CU\n", per_cu); per_cu = 1; }
        (void)hipGetLastError();
        grid = cus * per_cu;
        for (int i = 0; i < 32; ++i) invf[i] = 1.0f / powf(10000.0f, (float)(2 * i) / 64.0f);
    }
    if (grid < 0) return;
    Args a{};
    a.x = (const float*)d_in[0]; a.positions = (const int*)d_in[1]; a.mix_pre_g = (const float*)d_in[2]; a.mix_post_g = (const float*)d_in[3]; a.pool_w = (const float*)d_in[4];
    a.pool_scale = (const float*)d_in[5]; a.kv_norm_g = (const float*)d_in[6]; a.w_kv = (const float*)d_in[7]; a.w_q = (const float*)d_in[8]; a.w_o = (const float*)d_in[9];
    a.sinks = (const float*)d_in[10]; a.ffn_pre_g = (const float*)d_in[11]; a.ffn_post_g = (const float*)d_in[12]; a.ffn_w_in = (const float*)d_in[13]; a.ffn_conv_w = (const float*)d_in[14];
    a.ffn_conv_b = (const float*)d_in[15]; a.ffn_w_out = (const float*)d_in[16];
    a.out = (float*)d_out; a.ws = (unsigned char*)d_ws;
    for (int i = 0; i < 32; ++i) a.inv_freq[i] = invf[i];
#if defined(MK_PER_PHASE)
    for (int ph = 0; ph < NPH; ++ph) { a.ph_lo = ph; a.ph_hi = ph + 1; hipLaunchKernelGGL(yoco_fwd<false>, dim3(grid), dim3(NWAVES * 64), LDS_BYTES, stream, a); }
#else
    a.ph_lo = 0; a.ph_hi = NPH;
    (void)hipMemsetAsync((char*)d_ws + WS_CTL, 0, CTL_BYTES, stream);
    void* args[] = {&a};
    hipError_t e = hipLaunchCooperativeKernel((const void*)yoco_fwd<true>, dim3(grid), dim3(NWAVES * 64), args, LDS_BYTES, stream);
    if (e != hipSuccess) fprintf(stderr, "cooperative launch failed: %s (grid %d)\n", hipGetErrorString(e), grid);
#endif
}
```

```cpp
#include <hip/hip_runtime.h>
#include <hip/hip_cooperative_groups.h>
#include <cstdio>
#include <cstdint>
#include <cmath>
namespace cg = cooperative_groups;

#define LAS __attribute__((address_space(3)))
#define PG8_LAS LAS
typedef unsigned short bf16_t;
typedef short bf16x8 __attribute__((ext_vector_type(8)));
typedef float f32x4 __attribute__((ext_vector_type(4)));
typedef float f32x16 __attribute__((ext_vector_type(16)));
typedef unsigned u32x4 __attribute__((ext_vector_type(4)));
typedef unsigned u32x2 __attribute__((ext_vector_type(2)));
typedef float f32x2_t __attribute__((ext_vector_type(2)));
typedef __bf16 bf16x2_t __attribute__((ext_vector_type(2)));

constexpr int D = 1024, BATCH = 8, SEQ = 4096, M = BATCH * SEQ, DEPTH = 4, NA = 2, FF = 2816, FF2 = 5632;
constexpr int HD = 64, NQH = 16, NKVH = 4, NQKV = 1536;
constexpr float RMS_EPS = 1e-6f;
constexpr float LOG2E = 1.4426950408889634f;

__device__ __forceinline__ unsigned pk2(float lo, float hi) { f32x2_t v = {lo, hi}; bf16x2_t b = __builtin_convertvector(v, bf16x2_t); return __builtin_bit_cast(unsigned, b); }
typedef _Float16 h16x2 __attribute__((ext_vector_type(2)));
__device__ __forceinline__ unsigned pkh2(float lo, float hi) { h16x2 h = {(_Float16)lo, (_Float16)hi}; return __builtin_bit_cast(unsigned, h); }
__device__ __forceinline__ float h_lo(unsigned u) { return (float)__builtin_bit_cast(h16x2, u).x; }
__device__ __forceinline__ float h_hi(unsigned u) { return (float)__builtin_bit_cast(h16x2, u).y; }
__device__ __forceinline__ float bf_lo(unsigned u) { return __builtin_bit_cast(float, u << 16); }
__device__ __forceinline__ float bf_hi(unsigned u) { return __builtin_bit_cast(float, u & 0xffff0000u); }
template <int CTRL> __device__ __forceinline__ float dppf(float old, float src) {
    return __builtin_bit_cast(float, __builtin_amdgcn_update_dpp(__builtin_bit_cast(int, old), __builtin_bit_cast(int, src), CTRL, 0xf, 0xf, false));
}
constexpr int DPP_SHR1 = 0x111, DPP_SHR2 = 0x112, DPP_ROR1 = 0x121, DPP_ROR2 = 0x122;
__device__ __forceinline__ float gelu_tanh(float x) {
    const float c1 = -2.0f * 0.7978845608028654f * LOG2E, c2 = c1 * 0.044715f;
    const float t = x * (c1 + c2 * x * x);
    const float e = __builtin_amdgcn_exp2f(t);
    return x * __builtin_amdgcn_rcpf(1.0f + e);
}

__device__ __forceinline__ float rs_from_slots(const float* slots, int row) {
    const f32x4 v = *(const f32x4*)(slots + (size_t)row * 4);
    return 1.0f / sqrtf(((v[0] + v[1]) + (v[2] + v[3])) * (1.0f / 1024.0f) + RMS_EPS);
}
namespace pg8 {
constexpr int BM = 256, BK = 64, HALF = 128, HTB = HALF * BK * 2  , STAGE_BYTES = 8 * HTB, NXCD = 8, WGM = 8;
__host__ __device__ __forceinline__ int lds_byte(int r, int c) { const int st = (r >> 4) * 2 + (c >> 5), rr = r & 15, cc = c & 31, ob = rr * 64 + cc * 2; return st * 1024 + (ob ^ (((ob >> 9) & 1) << 5)); }
__host__ __device__ __forceinline__ void stage_rc(int b, int& R, int& C) { const int st = b / 1024, sb = b % 1024, swz = sb ^ (((sb >> 9) & 1) << 5); R = (st >> 1) * 16 + swz / 64; C = (st & 1) * 32 + (swz % 64) / 2; }
__host__ __device__ __forceinline__ int perm32(int rho) { const int n = rho >> 4, i = rho & 15; return 8 * (i >> 2) + 4 * n + (i & 3); }

typedef _Float16 f16x8 __attribute__((ext_vector_type(8)));
template <bool F16> __device__ __forceinline__ f32x4 mma16(bf16x8 a, bf16x8 b, f32x4 c) {
    if constexpr (F16) return __builtin_amdgcn_mfma_f32_16x16x32_f16(__builtin_bit_cast(f16x8, a), __builtin_bit_cast(f16x8, b), c, 0, 0, 0);
    else return __builtin_amdgcn_mfma_f32_16x16x32_bf16(a, b, c, 0, 0, 0);
}
struct Unit { int pm, pn; };
struct Gemm { const bf16_t* A; const bf16_t* Bt; int lda, ldb, K, acol; };

struct StaticOrder {
    int nM, nN, nwg, G, c;
    __host__ __device__ void init(int M_, int N_, int G_, int c_) { nM = M_ / BM; nN = N_ / BM; nwg = nM * nN; G = G_; c = c_; }
    __host__ __device__ bool next(int i, Unit& u) const {
        const long L = (long)i * G + c; if (L >= nwg) return false;
        int wgid = (int)L; { const int q = nwg / NXCD, r = nwg % NXCD, xcd = wgid % NXCD, off = wgid / NXCD; wgid = (xcd < r ? xcd * (q + 1) : r * (q + 1) + (xcd - r) * q) + off; }
        const int nig = WGM * nN, gid = wgid / nig, fm = gid * WGM, gsz = (nM - fm) < WGM ? (nM - fm) : WGM;
        u.pm = fm + ((wgid % nig) % gsz); u.pn = (wgid % nig) / gsz; return true;
    }
    __device__ __forceinline__ void a_ready(const Unit&) const {}
    __device__ __forceinline__ void done(const Unit&) const {}
};

struct RowStats {
    float* xbuf; unsigned* cnt;
    __device__ __forceinline__ void run(const f32x4 (&v)[2][2][4][2], const Unit& u, int wr, int wc, int fr, int fq, LAS unsigned char* xl, int wid, int lane) const {
        LAS float* P = (LAS float*)xl;
        LAS float* S = (LAS float*)(xl + 4096);
#pragma unroll
        for (int ai = 0; ai < 2; ++ai)
#pragma unroll
            for (int m = 0; m < 4; ++m) {
                float q = 0.f;
#pragma unroll
                for (int bj = 0; bj < 2; ++bj)
#pragma unroll
                    for (int n = 0; n < 2; ++n) { const f32x4 d = v[ai][bj][m][n]; q += (d[0] * d[0] + d[1] * d[1]) + (d[2] * d[2] + d[3] * d[3]); }
                q += __shfl_xor(q, 16); q += __shfl_xor(q, 32);
                if (fq == 0) P[(ai * HALF + wr * 64 + m * 16 + fr) * 4 + wc] = q;
            }
        asm volatile("s_waitcnt lgkmcnt(0)" ::: "memory"); __builtin_amdgcn_s_barrier(); asm volatile("" ::: "memory");
        const int row = wid * 32 + (lane & 31);
        if (lane < 32) {
            const float tot = (P[row * 4 + 0] + P[row * 4 + 1]) + (P[row * 4 + 2] + P[row * 4 + 3]);
            __hip_atomic_store(xbuf + ((size_t)(u.pm * BM + row) * 4 + u.pn), tot, __ATOMIC_RELAXED, __HIP_MEMORY_SCOPE_AGENT);
        }
        asm volatile("s_waitcnt vmcnt(0)" ::: "memory");
        if (lane == 0) __hip_atomic_fetch_add(cnt + 64 * u.pm, 1u, __ATOMIC_RELAXED, __HIP_MEMORY_SCOPE_AGENT);
        if (wid == 0) {
            unsigned sp = 0;
            for (;;) {
                if ((unsigned)__builtin_amdgcn_readfirstlane(__hip_atomic_load(cnt + 64 * u.pm, __ATOMIC_RELAXED, __HIP_MEMORY_SCOPE_AGENT)) >= 32u) break;
                if (++sp > (1u << 22)) break;
                __builtin_amdgcn_s_sleep(1);
            }
            __builtin_amdgcn_fence(__ATOMIC_ACQUIRE, "agent");
        }
        asm volatile("s_waitcnt vmcnt(0) lgkmcnt(0)" ::: "memory"); __builtin_amdgcn_s_barrier(); asm volatile("" ::: "memory");
        if (lane < 32) {
            const float* slot = xbuf + (size_t)(u.pm * BM + row) * 4; float q = 0.f;
#pragma unroll
            for (int t = 0; t < 4; ++t) q += __hip_atomic_load(slot + t, __ATOMIC_RELAXED, __HIP_MEMORY_SCOPE_AGENT);
            S[row] = 1.0f / sqrtf(q * (1.0f / 1024.0f) + RMS_EPS);
        }
        asm volatile("s_waitcnt lgkmcnt(0)" ::: "memory"); __builtin_amdgcn_s_barrier(); asm volatile("" ::: "memory");
    }
};
struct EpiResNorm {
    static constexpr bool PERM = false, AFTER_DRAIN = false, APERM = false, F16 = false;
    static __device__ __forceinline__ void partial(const f32x4 (&v)[2][2][4][2], const Unit& u, int wr, int wc, int fr, int fq, LAS unsigned char* xl, int wid, int lane, float* slots) {
        LAS float* P = (LAS float*)xl;
#pragma unroll
        for (int ai = 0; ai < 2; ++ai)
#pragma unroll
            for (int m = 0; m < 4; ++m) {
                float q = 0.f;
#pragma unroll
                for (int bj = 0; bj < 2; ++bj)
#pragma unroll
                    for (int n = 0; n < 2; ++n) { const f32x4 d = v[ai][bj][m][n]; q += (d[0] * d[0] + d[1] * d[1]) + (d[2] * d[2] + d[3] * d[3]); }
                q += __shfl_xor(q, 16); q += __shfl_xor(q, 32);
                if (fq == 0) P[(ai * HALF + wr * 64 + m * 16 + fr) * 4 + wc] = q;
            }
        asm volatile("s_waitcnt lgkmcnt(0)" ::: "memory"); __builtin_amdgcn_s_barrier(); asm volatile("" ::: "memory");
        if (lane < 32) { const int row = wid * 32 + lane; slots[(size_t)(u.pm * BM + row) * 4 + u.pn] = (P[row * 4 + 0] + P[row * 4 + 1]) + (P[row * 4 + 2] + P[row * 4 + 3]); }
    }
    const unsigned short* xsrc; void* xdst; int dst16; bf16_t* xn; const float* g; RowStats st1, st2;
    __device__ __forceinline__ void operator()(f32x4 (&acc)[2][2][4][2], const Unit& u, int wr, int wc, int fr_in, int fq_in, LAS unsigned char* xl) const {
        unsigned ones = ~0u; asm volatile("" : "+s"(ones));
        int lane = __builtin_amdgcn_mbcnt_hi(ones, __builtin_amdgcn_mbcnt_lo(ones, 0u)); asm volatile("" : "+v"(lane));
        const int fr = lane & 15, fq = lane >> 4; (void)fr_in; (void)fq_in;
        const int wid = wr * 4 + wc;
        const LAS float* S = (const LAS float*)(xl + 4096);
        const int col0 = u.pn * BM + wc * 32 + 4 * fq;
        u32x2 pre[2][4][2][2]; f32x4 gv[2][2];
#define RN_LD(ai, m) do { const unsigned off_ = (unsigned)(u.pm * BM + (ai) * HALF + wr * 64 + (m) * 16 + fr) * D + col0; \
            _Pragma("unroll") for (int bj = 0; bj < 2; ++bj) _Pragma("unroll") for (int n = 0; n < 2; ++n) pre[ai][m][bj][n] = *(const u32x2*)(xsrc + off_ + bj * HALF + n * 16); } while (0)
        RN_LD(0, 0); RN_LD(0, 1); RN_LD(0, 2); RN_LD(0, 3); RN_LD(1, 0); RN_LD(1, 1); RN_LD(1, 2); RN_LD(1, 3);
#undef RN_LD
#pragma unroll
        for (int bj = 0; bj < 2; ++bj)
#pragma unroll
            for (int n = 0; n < 2; ++n) gv[bj][n] = *(const f32x4*)(g + col0 + bj * HALF + n * 16);
        st1.run(acc, u, wr, wc, fr, fq, xl, wid, lane);
#pragma unroll
        for (int ai = 0; ai < 2; ++ai)
#pragma unroll
            for (int m = 0; m < 4; ++m) { const int r = ai * HALF + wr * 64 + m * 16 + fr; const float sr = S[r]; const unsigned off = (unsigned)(u.pm * BM + r) * D + col0;
#pragma unroll
                for (int bj = 0; bj < 2; ++bj)
#pragma unroll
                    for (int n = 0; n < 2; ++n) { const u32x2 p = pre[ai][m][bj][n];
                        const f32x4 x1 = (f32x4){h_lo(p.x), h_hi(p.x), h_lo(p.y), h_hi(p.y)} + acc[ai][bj][m][n] * sr * gv[bj][n]; acc[ai][bj][m][n] = x1;
                        if (dst16) { u32x2 w; w.x = pkh2(x1[0], x1[1]); w.y = pkh2(x1[2], x1[3]); *(u32x2*)((unsigned short*)xdst + off + bj * HALF + n * 16) = w; }
                        else *(f32x4*)((float*)xdst + off + bj * HALF + n * 16) = x1; }
                asm volatile("" : "+v"(acc[ai][0][m][0]), "+v"(acc[ai][0][m][1]), "+v"(acc[ai][1][m][0]), "+v"(acc[ai][1][m][1])); }
        if (xn) {
            partial(acc, u, wr, wc, fr, fq, xl, wid, lane, st2.xbuf);
        }
    }
};

struct EpiQKV {
    static constexpr bool PERM = true, AFTER_DRAIN = false, APERM = false, F16 = true;
    bf16_t* Q; bf16_t* Kb; bf16_t* Vt; const float* cs; const float* sn; const LAS float* rsl; int pm8;
    __device__ __forceinline__ void operator()(f32x4 (&acc)[2][2][4][2], const Unit& u, int wr, int wc, int fr, int fq, LAS unsigned char*) const {
#pragma unroll
        for (int ai = 0; ai < 2; ++ai)
#pragma unroll
            for (int m = 0; m < 4; ++m) { const float rs = rsl[((u.pm >> 3) - pm8) * 256 + ai * HALF + wr * 64 + m * 16 + fr];
#pragma unroll
                for (int bj = 0; bj < 2; ++bj)
#pragma unroll
                    for (int n = 0; n < 2; ++n) acc[ai][bj][m][n] = acc[ai][bj][m][n] * rs; }
        if (u.pn <= 4) {
            bf16_t* base; int ld, head;
            if (u.pn < 4) { base = Q; ld = D; head = u.pn * 4 + wc; } else { base = Kb; ld = 256; head = wc; }
#pragma unroll
            for (int ai = 0; ai < 2; ++ai)
#pragma unroll
                for (int m = 0; m < 4; ++m) {
                    const int row = u.pm * BM + ai * HALF + wr * 64 + m * 16 + fr;
                    const float* cp = cs + (size_t)row * 32 + 8 * fq; const float* sp = sn + (size_t)row * 32 + 8 * fq;
                    u32x4 w1, w2;
#pragma unroll
                    for (int n = 0; n < 2; ++n) {
                        const f32x4 c = *(const f32x4*)(cp + 4 * n), s = *(const f32x4*)(sp + 4 * n);
                        const f32x4 x1 = acc[ai][0][m][n], x2 = acc[ai][1][m][n];
                        const f32x4 o1 = x1 * c - x2 * s, o2 = x2 * c + x1 * s;
                        if (n == 0) { w1.x = pk2(o1[0], o1[1]); w1.y = pk2(o1[2], o1[3]); w2.x = pk2(o2[0], o2[1]); w2.y = pk2(o2[2], o2[3]); }
                        else        { w1.z = pk2(o1[0], o1[1]); w1.w = pk2(o1[2], o1[3]); w2.z = pk2(o2[0], o2[1]); w2.w = pk2(o2[2], o2[3]); }
                    }
                    bf16_t* op = base + (size_t)row * ld + head * 64 + 8 * fq;
                    *(u32x4*)op = w1; *(u32x4*)(op + 32) = w2;
                }
        } else {
            const int pos = (fr & 3) + 4 * ((fr >> 3) & 1) + 8 * ((fr >> 2) & 1);
#pragma unroll
            for (int ai = 0; ai < 2; ++ai)
#pragma unroll
                for (int m = 0; m < 4; ++m) {
                    const int row = u.pm * BM + ai * HALF + wr * 64 + m * 16;
                    const int b = row >> 12, s = (row & 4095) + pos;
#pragma unroll
                    for (int bj = 0; bj < 2; ++bj)
#pragma unroll
                        for (int n = 0; n < 2; ++n)
#pragma unroll
                            for (int e = 0; e < 4; ++e) {
                                const int c = bj * HALF + wc * 32 + 8 * fq + 4 * n + e, hk = c >> 6, d = c & 63;
                                Vt[((size_t)((b * NKVH + hk) * HD + d)) * SEQ + s] = (bf16_t)(pk2(acc[ai][bj][m][n][e], 0.f) & 0xffffu);
                            }
                }
        }
    }
};

struct EpiGlu {
    static constexpr bool PERM = true, AFTER_DRAIN = false, APERM = true, F16 = true;
    bf16_t* Aout; const float* cw; const float* cb; float* side; const LAS float* rsl; int pm8;
    __device__ __forceinline__ void operator()(f32x4 (&acc)[2][2][4][2], const Unit& u, int wr, int wc, int fr, int fq, LAS unsigned char* xl) const {
        LAS f32x4* X = (LAS f32x4*)xl;
        const int tc0 = wc * 32 + 8 * fq;
        f32x4 W[2][8];
#define GLU_LOADW(n) do { const int c0 = u.pn * 128 + tc0 + 4 * (n); \
            W[n][0] = *(const f32x4*)(cw + c0); W[n][1] = *(const f32x4*)(cw + FF2 + c0); W[n][2] = *(const f32x4*)(cw + 2 * FF2 + c0); W[n][3] = *(const f32x4*)(cb + c0); \
            W[n][4] = *(const f32x4*)(cw + FF + c0); W[n][5] = *(const f32x4*)(cw + FF2 + FF + c0); W[n][6] = *(const f32x4*)(cw + 2 * FF2 + FF + c0); W[n][7] = *(const f32x4*)(cb + FF + c0); } while (0)
        GLU_LOADW(0);
#pragma unroll
        for (int ai = 0; ai < 2; ++ai)
#pragma unroll
            for (int m = 0; m < 4; ++m) { const float rs = rsl[((u.pm >> 3) - pm8) * 256 + ai * HALF + wr * 64 + 4 * fr + m];
#pragma unroll
                for (int bj = 0; bj < 2; ++bj)
#pragma unroll
                    for (int n = 0; n < 2; ++n) acc[ai][bj][m][n] = acc[ai][bj][m][n] * rs; }
        if (fr == 15) {
#pragma unroll
            for (int ai = 0; ai < 2; ++ai)
#pragma unroll
                for (int bj = 0; bj < 2; ++bj)
#pragma unroll
                    for (int n = 0; n < 2; ++n) { X[((ai * 2 + wr) * 2 + 0) * 64 + ((bj * HALF + tc0 + 4 * n) >> 2)] = acc[ai][bj][2][n]; X[((ai * 2 + wr) * 2 + 1) * 64 + ((bj * HALF + tc0 + 4 * n) >> 2)] = acc[ai][bj][3][n]; }
        }
        if (wr == 0 && fr == 0) {
#pragma unroll
            for (int bj = 0; bj < 2; ++bj)
#pragma unroll
                for (int n = 0; n < 2; ++n) { *(f32x4*)(side + ((size_t)(u.pm * 4 + 0)) * FF2 + u.pn * 256 + bj * HALF + tc0 + 4 * n) = acc[0][bj][0][n]; *(f32x4*)(side + ((size_t)(u.pm * 4 + 1)) * FF2 + u.pn * 256 + bj * HALF + tc0 + 4 * n) = acc[0][bj][1][n]; }
        }
        if (wr == 1 && fr == 15) {
#pragma unroll
            for (int bj = 0; bj < 2; ++bj)
#pragma unroll
                for (int n = 0; n < 2; ++n) { *(f32x4*)(side + ((size_t)(u.pm * 4 + 2)) * FF2 + u.pn * 256 + bj * HALF + tc0 + 4 * n) = acc[1][bj][2][n]; *(f32x4*)(side + ((size_t)(u.pm * 4 + 3)) * FF2 + u.pn * 256 + bj * HALF + tc0 + 4 * n) = acc[1][bj][3][n]; }
        }
        asm volatile("s_waitcnt lgkmcnt(0)" ::: "memory"); __builtin_amdgcn_s_barrier(); asm volatile("" ::: "memory");
        const int row0 = u.pm * BM + wr * 64 + 4 * fr;
        const float c1 = -2.0f * 0.7978845608028654f * LOG2E, c2 = c1 * 0.044715f;
#pragma unroll
        for (int n = 0; n < 2; ++n) {
#pragma unroll
            for (int ai = 0; ai < 2; ++ai) {
                if (n == 0 && ai == 1) GLU_LOADW(1);
                const int sidx = ai * 2 + wr;
                f32x4 g2h = (f32x4){0.f, 0.f, 0.f, 0.f}, g3h = g2h, v2h = g2h, v3h = g2h;
                if (sidx > 0) { g2h = X[((sidx - 1) * 2 + 0) * 64 + ((tc0 + 4 * n) >> 2)]; g3h = X[((sidx - 1) * 2 + 1) * 64 + ((tc0 + 4 * n) >> 2)];
                                v2h = X[((sidx - 1) * 2 + 0) * 64 + ((HALF + tc0 + 4 * n) >> 2)]; v3h = X[((sidx - 1) * 2 + 1) * 64 + ((HALF + tc0 + 4 * n) >> 2)]; }
                f32x4 G2, G3, V2, V3;
#pragma unroll
                for (int e = 0; e < 4; ++e) { G2[e] = dppf<DPP_SHR1>(g2h[e], acc[ai][0][2][n][e]); G3[e] = dppf<DPP_SHR1>(g3h[e], acc[ai][0][3][n][e]);
                                              V2[e] = dppf<DPP_SHR1>(v2h[e], acc[ai][1][2][n][e]); V3[e] = dppf<DPP_SHR1>(v3h[e], acc[ai][1][3][n][e]); }
#pragma unroll
                for (int m = 0; m < 4; ++m) {
                    const f32x4 g0 = acc[ai][0][m][n], v0 = acc[ai][1][m][n];
                    const f32x4 g1 = (m == 0) ? G3 : acc[ai][0][m - 1 < 0 ? 0 : m - 1][n], gm2 = (m == 0) ? G2 : (m == 1) ? G3 : acc[ai][0][m - 2 < 0 ? 0 : m - 2][n];
                    const f32x4 v1 = (m == 0) ? V3 : acc[ai][1][m - 1 < 0 ? 0 : m - 1][n], vm2 = (m == 0) ? V2 : (m == 1) ? V3 : acc[ai][1][m - 2 < 0 ? 0 : m - 2][n];
                    const f32x4 cgv = W[n][3] + W[n][2] * g0 + W[n][1] * g1 + W[n][0] * gm2;
                    const f32x4 cvv = W[n][7] + W[n][6] * v0 + W[n][5] * v1 + W[n][4] * vm2;
                    unsigned ow[2];
#pragma unroll
                    for (int h = 0; h < 2; ++h) {
                        const f32x2_t x = {cgv[2 * h], cgv[2 * h + 1]}, y = {cvv[2 * h], cvv[2 * h + 1]};
                        const f32x2_t t = x * (x * x * c2 + c1);
                        f32x2_t d; d.x = __builtin_amdgcn_exp2f(t.x); d.y = __builtin_amdgcn_exp2f(t.y); d = d + 1.0f;
                        f32x2_t r; r.x = __builtin_amdgcn_rcpf(d.x); r.y = __builtin_amdgcn_rcpf(d.y);
                        const f32x2_t o = (x * y) * r;
                        ow[h] = pk2(o.x, o.y);
                    }
                    u32x2 w; w.x = ow[0]; w.y = ow[1];
                    *(u32x2*)(Aout + (size_t)(row0 + ai * HALF + m) * FF + u.pn * 128 + tc0 + 4 * n) = w;
                }
                __builtin_amdgcn_sched_barrier(0);
            }
        }
#undef GLU_LOADW
    }
};

template <class Epi, class Sched, bool ALIGN_EPI = false, bool SP2 = false>
__device__ __forceinline__ void gemm_phase(PG8_LAS unsigned char* lds, const Gemm g, const Sched& S, const Epi& E, const int tid) {
    const int wid = __builtin_amdgcn_readfirstlane(tid >> 6), lane = tid & 63, wr = wid >> 2, wc = wid & 3, fr = lane & 15, fq = lane >> 4;
    const int K = g.K, nt = K / BK;
    unsigned voffA[2], voffB[2];
#pragma unroll
    for (int i = 0; i < 2; ++i) { int R, C; stage_rc(tid * 16 + i * 8192, R, C); const int Rb = Epi::PERM ? ((R & ~31) + perm32(R & 31)) : R;
        const int Ra = Epi::APERM ? ((R & 64) + 4 * (R & 15) + ((R >> 4) & 3)) : R;
        voffA[i] = (unsigned)(Ra * g.lda + C) * 2u; voffB[i] = (unsigned)(Rb * g.ldb + C) * 2u; }
    const size_t kstep = (size_t)(BK * 2);
    const size_t hstepA = (size_t)HALF * g.lda * 2, hstepB = (size_t)HALF * g.ldb * 2;
    const size_t tstepA = 2 * hstepA, tstepB = 2 * hstepB;
    const unsigned ldsw = (unsigned)wid * 1024u;
    const int aoff = lds_byte(wr * 64 + fr, fq * 8), boff = lds_byte(wc * 32 + fr, fq * 8);
#define PG8_SA(b, h) (((b) * 2 + (h)) * HTB)
#define PG8_SB(b, h) ((4 + (b) * 2 + (h)) * HTB)
#define PG8_STAGE(bufoff, gbase, voff) do { _Pragma("unroll") for (int _i = 0; _i < 2; ++_i) \
        __builtin_amdgcn_global_load_lds((const unsigned*)((const char*)(gbase) + (voff)[_i]), (PG8_LAS unsigned*)(lds + (bufoff) + ldsw + _i * 8192), 16, 0, 0); } while (0)
#define PG8_LDA(dst, b, h) do { _Pragma("unroll") for (int m = 0; m < 4; ++m) _Pragma("unroll") for (int k = 0; k < 2; ++k) dst[m][k] = *(const PG8_LAS bf16x8*)(lds + PG8_SA(b, h) + aoff + m * 2048 + k * 1024); } while (0)
#define PG8_LDB(dst, b, h) do { _Pragma("unroll") for (int n = 0; n < 2; ++n) _Pragma("unroll") for (int k = 0; k < 2; ++k) dst[n][k] = *(const PG8_LAS bf16x8*)(lds + PG8_SB(b, h) + boff + n * 2048 + k * 1024); } while (0)
#define PG8_MMA(ai, bj, At, Bt) do { __builtin_amdgcn_s_setprio(1); _Pragma("unroll") for (int m = 0; m < 4; ++m) _Pragma("unroll") for (int n = 0; n < 2; ++n) _Pragma("unroll") for (int k = 0; k < 2; ++k) \
        acc[ai][bj][m][n] = mma16<Epi::F16>(Bt[n][k], At[m][k], acc[ai][bj][m][n]); __builtin_amdgcn_s_setprio(0); } while (0)
#define PG8_WAIT_V(n) asm volatile("s_waitcnt vmcnt(" #n ")" ::: "memory")
#define PG8_WAIT_L(n) asm volatile("s_waitcnt lgkmcnt(" #n ")" ::: "memory")
#define PG8_BAR __builtin_amdgcn_s_barrier()
#define PG8_SCHED __builtin_amdgcn_sched_barrier(0)
    Unit cur, nxt; int ui = 0;
    if (!S.next(0, cur)) return;
    f32x4 acc[2][2][4][2];
#pragma unroll
    for (int a = 0; a < 2; ++a)
#pragma unroll
        for (int b = 0; b < 2; ++b)
#pragma unroll
            for (int m = 0; m < 4; ++m)
#pragma unroll
                for (int n = 0; n < 2; ++n) acc[a][b][m][n] = (f32x4){0.f, 0.f, 0.f, 0.f};
    bf16x8 At[4][2], B0[2][2], B1[2][2];
    const char* cA = (const char*)g.A + (size_t)cur.pm * tstepA + (size_t)cur.pn * g.acol * 2; const char* cB = (const char*)g.Bt + (size_t)cur.pn * tstepB;
    S.a_ready(cur);
    if constexpr (SP2) {
        PG8_STAGE(PG8_SB(0, 0), cB, voffB); PG8_STAGE(PG8_SB(0, 1), cB + hstepB, voffB); PG8_STAGE(PG8_SA(0, 0), cA, voffA); PG8_STAGE(PG8_SA(0, 1), cA + hstepA, voffA);
        if (wr == 1) PG8_BAR;
        PG8_WAIT_V(2); PG8_BAR;
        PG8_STAGE(PG8_SB(1, 0), cB + kstep, voffB); PG8_STAGE(PG8_SA(1, 0), cA + kstep, voffA); PG8_STAGE(PG8_SB(1, 1), cB + hstepB + kstep, voffB);
        PG8_WAIT_V(6); PG8_BAR;
    } else {
        PG8_STAGE(PG8_SB(0, 0), cB, voffB); PG8_STAGE(PG8_SA(0, 0), cA, voffA); PG8_STAGE(PG8_SB(0, 1), cB + hstepB, voffB); PG8_STAGE(PG8_SA(0, 1), cA + hstepA, voffA);
        if (wr == 1) PG8_BAR;
        PG8_WAIT_V(4); PG8_BAR;
        PG8_STAGE(PG8_SB(1, 0), cB + kstep, voffB); PG8_STAGE(PG8_SA(1, 0), cA + kstep, voffA); PG8_STAGE(PG8_SB(1, 1), cB + hstepB + kstep, voffB);
        PG8_WAIT_V(6); PG8_BAR;
    }
    for (;;) {
        const bool has_next = S.next(ui + 1, nxt);
        const char* nA = has_next ? (const char*)g.A + (size_t)nxt.pm * tstepA + (size_t)nxt.pn * g.acol * 2 : cA; const char* nB = has_next ? (const char*)g.Bt + (size_t)nxt.pn * tstepB : cB;
        for (int t = 0; t < nt; t += 2) {
            const bool last = (t == nt - 2);
            const char* a1 = cA + (size_t)(t + 1) * kstep;
            const char* a2 = last ? nA : cA + (size_t)(t + 2) * kstep; const char* b2 = last ? nB : cB + (size_t)(t + 2) * kstep;
            const char* a3 = a2 + kstep; const char* b3 = b2 + kstep;
            if (last && has_next) S.a_ready(nxt);
            if constexpr (SP2) {
            PG8_LDB(B0, 0, 0); PG8_LDB(B1, 0, 1); PG8_SCHED; PG8_LDA(At, 0, 0); PG8_STAGE(PG8_SA(1, 1), a1 + hstepA, voffA);
            PG8_WAIT_V(8); PG8_WAIT_L(0); PG8_BAR; PG8_MMA(0, 0, At, B0); PG8_MMA(0, 1, At, B1); PG8_BAR; PG8_SCHED;
            PG8_LDA(At, 0, 1); PG8_STAGE(PG8_SB(0, 0), b2, voffB); PG8_STAGE(PG8_SB(0, 1), b2 + hstepB, voffB); PG8_STAGE(PG8_SA(0, 0), a2, voffA);
            PG8_WAIT_V(8); PG8_WAIT_L(0); PG8_BAR; PG8_MMA(1, 0, At, B0); PG8_MMA(1, 1, At, B1); PG8_BAR; PG8_SCHED;
            PG8_LDB(B0, 1, 0); PG8_LDB(B1, 1, 1); PG8_SCHED; PG8_LDA(At, 1, 0); PG8_STAGE(PG8_SA(0, 1), a2 + hstepA, voffA);
            PG8_WAIT_V(8); PG8_WAIT_L(0); PG8_BAR; PG8_MMA(0, 0, At, B0); PG8_MMA(0, 1, At, B1); PG8_BAR; PG8_SCHED;
            PG8_LDA(At, 1, 1); PG8_STAGE(PG8_SB(1, 0), b3, voffB); PG8_STAGE(PG8_SB(1, 1), b3 + hstepB, voffB); PG8_STAGE(PG8_SA(1, 0), a3, voffA);
            PG8_WAIT_V(8); PG8_WAIT_L(0); PG8_BAR; PG8_MMA(1, 0, At, B0); PG8_MMA(1, 1, At, B1); PG8_BAR; PG8_SCHED;
            } else {
            PG8_LDB(B0, 0, 0); PG8_SCHED; PG8_LDA(At, 0, 0); PG8_STAGE(PG8_SA(1, 1), a1 + hstepA, voffA);
            PG8_WAIT_L(8); PG8_BAR; PG8_WAIT_L(0); PG8_MMA(0, 0, At, B0); PG8_BAR; PG8_SCHED;
            PG8_LDB(B1, 0, 1); PG8_STAGE(PG8_SB(0, 0), b2, voffB);
            PG8_BAR; PG8_WAIT_L(0); PG8_MMA(0, 1, At, B1); PG8_BAR;
            PG8_LDA(At, 0, 1); PG8_STAGE(PG8_SA(0, 0), a2, voffA);
            PG8_BAR; PG8_WAIT_L(0); PG8_MMA(1, 0, At, B0); PG8_BAR; PG8_SCHED;
            PG8_STAGE(PG8_SB(0, 1), b2 + hstepB, voffB);
            PG8_WAIT_V(6); PG8_BAR; PG8_MMA(1, 1, At, B1); PG8_BAR;
            PG8_LDB(B0, 1, 0); PG8_SCHED; PG8_LDA(At, 1, 0); PG8_STAGE(PG8_SA(0, 1), a2 + hstepA, voffA);
            PG8_WAIT_L(8); PG8_BAR; PG8_WAIT_L(0); PG8_MMA(0, 0, At, B0); PG8_BAR; PG8_SCHED;
            PG8_LDB(B1, 1, 1); PG8_STAGE(PG8_SB(1, 0), b3, voffB);
            PG8_BAR; PG8_WAIT_L(0); PG8_MMA(0, 1, At, B1); PG8_BAR;
            PG8_LDA(At, 1, 1); PG8_STAGE(PG8_SA(1, 0), a3, voffA);
            PG8_BAR; PG8_WAIT_L(0); PG8_MMA(1, 0, At, B0); PG8_BAR; PG8_SCHED;
            PG8_STAGE(PG8_SB(1, 1), b3 + hstepB, voffB);
            PG8_WAIT_V(6); PG8_BAR; PG8_MMA(1, 1, At, B1); PG8_BAR;
            }
        }
        if constexpr (ALIGN_EPI) { if (wr == 0) PG8_BAR; }
        if constexpr (!Epi::AFTER_DRAIN) { E(acc, cur, wr, wc, fr, fq, lds + STAGE_BYTES); S.done(cur); }
        if (!has_next) break;
#pragma unroll
        for (int a = 0; a < 2; ++a)
#pragma unroll
            for (int b = 0; b < 2; ++b)
#pragma unroll
                for (int m = 0; m < 4; ++m)
#pragma unroll
                    for (int n = 0; n < 2; ++n) acc[a][b][m][n] = (f32x4){0.f, 0.f, 0.f, 0.f};
        cur = nxt; cA = nA; cB = nB; ++ui;
        if constexpr (ALIGN_EPI) { if (wr == 1) PG8_BAR; }
    }
    PG8_WAIT_V(0);
    if constexpr (!ALIGN_EPI) { if (wr == 0) PG8_BAR; }
    PG8_BAR;
    if constexpr (Epi::AFTER_DRAIN) { E.fused(acc, cur, wr, wc, fr, fq, lds, wid, lane); S.done(cur); }
#undef PG8_SA
#undef PG8_SB
#undef PG8_STAGE
#undef PG8_LDA
#undef PG8_LDB
#undef PG8_MMA
#undef PG8_WAIT_V
#undef PG8_WAIT_L
#undef PG8_BAR
#undef PG8_SCHED
}
}

constexpr size_t MiB = 1u << 20;
constexpr size_t WS_BT1 = 0;
constexpr size_t WS_BT2 = 44 * MiB;
constexpr size_t WS_BTQKV = 66 * MiB;
constexpr size_t WS_BTO = 71 * MiB;
constexpr size_t WS_BTP = 75 * MiB;
constexpr size_t WS_COS = 76 * MiB, WS_SIN = 80 * MiB;
constexpr size_t WS_SIDE = 84 * MiB;
constexpr size_t WS_XN = 96 * MiB;
constexpr size_t WS_T = 160 * MiB;
constexpr size_t WS_K = 224 * MiB, WS_VT = 240 * MiB;
constexpr size_t WS_A = 256 * MiB;
constexpr size_t WS_CTL = 432 * MiB, CTL_BYTES = 4 * MiB;
constexpr size_t WS_XH = 440 * MiB;
constexpr size_t WS_END = 504 * MiB;
constexpr int CW_SEAM = 16384;

constexpr int LDS_BYTES = 147456;
constexpr int NWAVES = 8;

struct Args {
    const float* x; const int* positions; const float* mix_pre_g; const float* mix_post_g; const float* pool_w; const float* pool_scale;
    const float* kv_norm_g; const float* w_kv; const float* w_q; const float* w_o; const float* sinks; const float* ffn_pre_g; const float* ffn_post_g;
    const float* ffn_w_in; const float* ffn_conv_w; const float* ffn_conv_b; const float* ffn_w_out;
    float* out; unsigned char* ws;
    float inv_freq[32];
    int ph_lo, ph_hi;
};

__device__ __forceinline__ float wave_sum(float v) {
#pragma unroll
    for (int o = 1; o < 64; o <<= 1) v += __shfl_xor(v, o);
    return v;
}

__device__ __forceinline__ void transpose_item(const float* W, int ldw, int k0, int n0, bf16_t* WT, int ldo, int orow0, const float* gk, const float* gn, float cst, LAS float* scr, int lane, bool f16 = false) {
    { const int kq = lane >> 3, nq = lane & 7; f32x4 v[8];
#pragma unroll
      for (int i = 0; i < 8; ++i) v[i] = *(const f32x4*)(W + (size_t)(k0 + i * 8 + kq) * ldw + n0 + 4 * nq);
#pragma unroll
      for (int i = 0; i < 8; ++i) { const int kk = i * 8 + kq; const float gg = gk ? gk[k0 + kk] : 1.0f; LAS float* d = scr + kk * 33 + 4 * nq; d[0] = v[i][0] * gg; d[1] = v[i][1] * gg; d[2] = v[i][2] * gg; d[3] = v[i][3] * gg; } }
    asm volatile("s_waitcnt lgkmcnt(0)" ::: "memory");
    const int c = lane & 7;
#pragma unroll
    for (int j = 0; j < 4; ++j) { const int n = (lane >> 3) + 8 * j; const LAS float* s = scr + (8 * c) * 33 + n;
        const float gg = (gn ? gn[n0 + n] : 1.0f) * cst;
        u32x4 o; o.x = pk2(s[0 * 33] * gg, s[1 * 33] * gg); o.y = pk2(s[2 * 33] * gg, s[3 * 33] * gg); o.z = pk2(s[4 * 33] * gg, s[5 * 33] * gg); o.w = pk2(s[6 * 33] * gg, s[7 * 33] * gg);
        if (f16) { o.x = pkh2(s[0 * 33] * gg, s[1 * 33] * gg); o.y = pkh2(s[2 * 33] * gg, s[3 * 33] * gg); o.z = pkh2(s[4 * 33] * gg, s[5 * 33] * gg); o.w = pkh2(s[6 * 33] * gg, s[7 * 33] * gg); }
        *(u32x4*)(WT + (size_t)(orow0 + n) * ldo + k0 + 8 * c) = o; }
    asm volatile("s_waitcnt lgkmcnt(0)" ::: "memory");
}

__device__ __forceinline__ void row_phase(const float* xsrc, const bf16_t* t, const float* g, float* xdst, bf16_t* xn, float* slots, unsigned short* xh, int gw, int NGW, int lane) {
    f32x4 gv[4];
#pragma unroll
    for (int j = 0; j < 4; ++j) gv[j] = g ? *(const f32x4*)(g + 4 * lane + 256 * j) : (f32x4){0.f, 0.f, 0.f, 0.f};
    f32x4 xv[4], xnx[4]; u32x2 tw[4], tnx[4];
    if (gw < M) {
#pragma unroll
        for (int j = 0; j < 4; ++j) { xv[j] = *(const f32x4*)(xsrc + (size_t)gw * D + 4 * lane + 256 * j); tw[j] = t ? *(const u32x2*)(t + (size_t)gw * D + 4 * lane + 256 * j) : (u32x2){0u, 0u}; }
    }
    for (int m = gw; m < M; m += NGW) {
        const int mn = m + NGW;
        if (mn < M) {
#pragma unroll
            for (int j = 0; j < 4; ++j) { xnx[j] = *(const f32x4*)(xsrc + (size_t)mn * D + 4 * lane + 256 * j); tnx[j] = t ? *(const u32x2*)(t + (size_t)mn * D + 4 * lane + 256 * j) : (u32x2){0u, 0u}; }
        }
        if (t) {
            f32x4 tv[4]; float ss = 0.f;
#pragma unroll
            for (int j = 0; j < 4; ++j) { const u32x2 w = tw[j];
                tv[j] = (f32x4){bf_lo(w.x), bf_hi(w.x), bf_lo(w.y), bf_hi(w.y)}; ss += (tv[j][0] * tv[j][0] + tv[j][1] * tv[j][1]) + (tv[j][2] * tv[j][2] + tv[j][3] * tv[j][3]); }
            const float rs = 1.0f / sqrtf(wave_sum(ss) * (1.0f / D) + RMS_EPS);
#pragma unroll
            for (int j = 0; j < 4; ++j) xv[j] += tv[j] * rs * gv[j];
        }
        if (xdst) {
#pragma unroll
            for (int j = 0; j < 4; ++j) *(f32x4*)(xdst + (size_t)m * D + 4 * lane + 256 * j) = xv[j];
        }
        if (xn) {
            float s2 = 0.f;
#pragma unroll
            for (int j = 0; j < 4; ++j) s2 += (xv[j][0] * xv[j][0] + xv[j][1] * xv[j][1]) + (xv[j][2] * xv[j][2] + xv[j][3] * xv[j][3]);
            const float wave_sum_s2 = wave_sum(s2);
#pragma unroll
            for (int j = 0; j < 4; ++j) { u32x2 w; w.x = pkh2(xv[j][0], xv[j][1]); w.y = pkh2(xv[j][2], xv[j][3]); *(u32x2*)(xh + (size_t)m * D + 4 * lane + 256 * j) = w; }
            if (lane == 0) *(f32x4*)(slots + (size_t)m * 4) = (f32x4){wave_sum_s2, 0.f, 0.f, 0.f};
        }
#pragma unroll
        for (int j = 0; j < 4; ++j) { xv[j] = xnx[j]; tw[j] = tnx[j]; }
    }
}

__device__ __forceinline__ void add8(float (&a)[8], const u32x4 v, float sgn) {
    a[0] += sgn * h_lo(v.x); a[1] += sgn * h_hi(v.x); a[2] += sgn * h_lo(v.y); a[3] += sgn * h_hi(v.y); a[4] += sgn * h_lo(v.z); a[5] += sgn * h_hi(v.z); a[6] += sgn * h_lo(v.w); a[7] += sgn * h_hi(v.w);
}
__device__ __forceinline__ void diff_tile(const bf16_t* xn, const float* slots, bf16_t* dd, int pm, int pn, int tid) {
    const int c = pn * 32 + (tid & 31), t0 = pm * 256 + (tid >> 5) * 16, ts0 = t0 & (SEQ - 1), w = 2 << pn;
    const bf16_t* base = xn + (size_t)t0 * D + 8 * c;
    float S[8] = {0.f, 0.f, 0.f, 0.f, 0.f, 0.f, 0.f, 0.f};
#pragma unroll
    for (int k = 1; k < 16; ++k) { if (k < w && ts0 - k >= 0) add8(S, *(const u32x4*)(base - (size_t)k * D), rs_from_slots(slots, t0 - k)); }
#pragma unroll 1
    for (int i0 = 0; i0 < 16; i0 += 8) {
        u32x4 cur[8], old[8];
#pragma unroll
        for (int i = 0; i < 8; ++i) { cur[i] = *(const u32x4*)(base + (size_t)(i0 + i) * D);
            old[i] = (i0 + i > 0 && ts0 + i0 + i - w >= 0) ? *(const u32x4*)(base + (size_t)(i0 + i - w) * D) : (u32x4){0u, 0u, 0u, 0u}; }
#pragma unroll
        for (int i = 0; i < 8; ++i) {
            const int ts = ts0 + i0 + i;
            if (i0 + i > 0 && ts - w >= 0) add8(S, old[i], -rs_from_slots(slots, t0 + i0 + i - w));
            const float rc = rs_from_slots(slots, t0 + i0 + i);
            add8(S, cur[i], rc);
            const float ic = 1.0f / (float)((ts + 1) < w ? (ts + 1) : w);
            const u32x4 v = cur[i];
            u32x4 o; o.x = pk2(S[0] * ic - rc * h_lo(v.x), S[1] * ic - rc * h_hi(v.x)); o.y = pk2(S[2] * ic - rc * h_lo(v.y), S[3] * ic - rc * h_hi(v.y));
            o.z = pk2(S[4] * ic - rc * h_lo(v.z), S[5] * ic - rc * h_hi(v.z)); o.w = pk2(S[6] * ic - rc * h_lo(v.w), S[7] * ic - rc * h_hi(v.w));
            *(u32x4*)(dd + (size_t)(t0 + i0 + i) * D + 8 * c) = o;
        }
    }
}

__device__ __forceinline__ void fixup_tile(const float* side, const float* cw, const float* cb, bf16_t* Aout, int pm, int tid) {
    for (int idx = tid; idx < 2 * (FF / 4); idx += NWAVES * 64) {
        const int c = 4 * (idx % (FF / 4)), i = idx / (FF / 4);
        const int sc = (c >> 7) * 256 + (c & 127);
        const f32x4 z = (f32x4){0.f, 0.f, 0.f, 0.f};
        const bool first = (pm & 15) == 0;
        const float* sp = side + (size_t)pm * 4 * FF2 + sc; const float* pp = sp - 4 * FF2;
        f32x4 o;
        {
            const f32x4 gm2 = first ? z : *(const f32x4*)(pp + 2 * FF2), gm1 = first ? z : *(const f32x4*)(pp + 3 * FF2), g0 = *(const f32x4*)(sp), g1 = *(const f32x4*)(sp + FF2);
            const f32x4 vm2 = first ? z : *(const f32x4*)(pp + 2 * FF2 + 128), vm1 = first ? z : *(const f32x4*)(pp + 3 * FF2 + 128), v0 = *(const f32x4*)(sp + 128), v1 = *(const f32x4*)(sp + FF2 + 128);
            const f32x4 wg0 = *(const f32x4*)(cw + c), wg1 = *(const f32x4*)(cw + FF2 + c), wg2 = *(const f32x4*)(cw + 2 * FF2 + c), bg = *(const f32x4*)(cb + c);
            const f32x4 wv0 = *(const f32x4*)(cw + FF + c), wv1 = *(const f32x4*)(cw + FF2 + FF + c), wv2 = *(const f32x4*)(cw + 2 * FF2 + FF + c), bv = *(const f32x4*)(cb + FF + c);
            const f32x4 cgv = (i == 0) ? (wg2 * g0 + wg1 * gm1 + wg0 * gm2 + bg) : (wg2 * g1 + wg1 * g0 + wg0 * gm1 + bg);
            const f32x4 cvv = (i == 0) ? (wv2 * v0 + wv1 * vm1 + wv0 * vm2 + bv) : (wv2 * v1 + wv1 * v0 + wv0 * vm1 + bv);
#pragma unroll
            for (int e = 0; e < 4; ++e) o[e] = gelu_tanh(cgv[e]) * cvv[e];
        }
        u32x2 w; w.x = pk2(o[0], o[1]); w.y = pk2(o[2], o[3]);
        *(u32x2*)(Aout + (size_t)(pm * 256 + i) * FF + c) = w;
    }
}

constexpr int AT_KROW = 144, AT_VROW = 528, AT_VOFF = 256 * AT_KROW;
__device__ __forceinline__ void attn_phase(LAS unsigned char* lds, const bf16_t* Q, const bf16_t* Kb, const bf16_t* Vt, bf16_t* O, const float* sinks, int blk, int G, int wave, int lane, int tid) {
    const int q = lane & 31, hi = lane >> 5;
    const int NU = BATCH * NKVH * 32, UPB = (NU + G - 1) / G;
    u32x4 kr[4], vr[4];
#define AT_LOAD(u_) do { const int b_ = (u_) >> 7, hk_ = ((u_) >> 5) & 3, nb_ = (u_) & 31; \
        int kp_ = nb_ * 128 - 128 + (tid >> 1); if (kp_ < 0) kp_ += 128; \
        int vp_ = nb_ * 128 - 128 + (tid & 7) * 32; if (vp_ < 0) vp_ += 128; \
        const bf16_t* ks_ = Kb + (size_t)(b_ * SEQ + kp_) * 256 + hk_ * 64 + (tid & 1) * 32; \
        const bf16_t* vs_ = Vt + ((size_t)((b_ * NKVH + hk_) * HD + (tid >> 3))) * SEQ + vp_; \
        _Pragma("unroll") for (int j_ = 0; j_ < 4; ++j_) { kr[j_] = *(const u32x4*)(ks_ + j_ * 8); vr[j_] = *(const u32x4*)(vs_ + j_ * 8); } } while (0)
    for (int i = 0; i < UPB; ++i) {
        const int u = blk * UPB + i; if (u >= NU) break;
        const int b = u >> 7, hk = (u >> 5) & 3, nb = u & 31;
        if (i == 0) AT_LOAD(u);
        __syncthreads();
#pragma unroll
        for (int j = 0; j < 4; ++j) { *(LAS u32x4*)(lds + (tid >> 1) * AT_KROW + (tid & 1) * 64 + j * 16) = kr[j]; *(LAS u32x4*)(lds + AT_VOFF + (tid >> 3) * AT_VROW + (tid & 7) * 64 + j * 16) = vr[j]; }
        __syncthreads();
        if (i + 1 < UPB && u + 1 < NU) AT_LOAD(u + 1);
        const int gq = wave >> 1, hq = hk * 4 + gq;
        const float sink2 = sinks[hq] * LOG2E;
#pragma unroll 1
        for (int t = 0; t < 2; ++t) {
            const int sb = 2 * (wave & 1) + t;
            const int row0 = b * SEQ + nb * 128 + sb * 32;
            bf16x8 qf[4];
            { const bf16_t* qp = Q + (size_t)(row0 + q) * D + hq * 64 + hi * 8;
#pragma unroll
              for (int s = 0; s < 4; ++s) qf[s] = *(const bf16x8*)(qp + s * 16); }
            f32x16 st[5];
            const LAS unsigned char* kl = lds + (32 * sb + q) * AT_KROW + hi * 16;
#pragma unroll
            for (int kbi = 0; kbi < 5; ++kbi) {
                f32x16 a = {};
#pragma unroll
                for (int s = 0; s < 4; ++s) { const bf16x8 kf = *(const LAS bf16x8*)(kl + kbi * 32 * AT_KROW + s * 32); a = __builtin_amdgcn_mfma_f32_32x32x16_bf16(kf, qf[s], a, 0, 0, 0); }
                st[kbi] = a;
            }
            const float NEG = -1e30f;
#pragma unroll
            for (int kbi = 0; kbi < 5; ++kbi) {
                const bool dead = (nb == 0) && (sb + kbi < 4);
#pragma unroll
                for (int r = 0; r < 16; ++r) {
                    const int kk = (r & 3) + 8 * (r >> 2) + 4 * hi;
                    bool ok = !dead;
                    if (kbi == 0) ok = ok && (kk > q);
                    if (kbi == 4) ok = ok && (kk <= q);
                    st[kbi][r] = ok ? st[kbi][r] : NEG;
                }
            }
            float mx = sink2;
#pragma unroll
            for (int kbi = 0; kbi < 5; ++kbi)
#pragma unroll
                for (int r = 0; r < 16; ++r) mx = fmaxf(mx, st[kbi][r]);
            mx = fmaxf(mx, __shfl_xor(mx, 32));
            float sum = 0.f;
            bf16x8 pw[5][2];
#pragma unroll
            for (int kbi = 0; kbi < 5; ++kbi) {
                float p[16];
#pragma unroll
                for (int r = 0; r < 16; ++r) { p[r] = __builtin_amdgcn_exp2f(st[kbi][r] - mx); sum += p[r]; }
#pragma unroll
                for (int h = 0; h < 2; ++h) { u32x4 w; w.x = pk2(p[8 * h + 0], p[8 * h + 1]); w.y = pk2(p[8 * h + 2], p[8 * h + 3]); w.z = pk2(p[8 * h + 4], p[8 * h + 5]); w.w = pk2(p[8 * h + 6], p[8 * h + 7]);
                    pw[kbi][h] = __builtin_bit_cast(bf16x8, w); }
            }
            sum += __shfl_xor(sum, 32);
            const float inv = 1.0f / (sum + __builtin_amdgcn_exp2f(sink2 - mx));
            f32x16 ot[2]; ot[0] = f32x16{}; ot[1] = f32x16{};
            const LAS unsigned char* vl = lds + AT_VOFF + q * AT_VROW + (32 * sb + hi * 8) * 2;
#pragma unroll
            for (int kbi = 0; kbi < 5; ++kbi)
#pragma unroll
                for (int h = 0; h < 2; ++h)
#pragma unroll
                    for (int dh = 0; dh < 2; ++dh) {
                        const bf16x8 vf = *(const LAS bf16x8*)(vl + dh * 32 * AT_VROW + (kbi * 32 + h * 16) * 2);
                        ot[dh] = __builtin_amdgcn_mfma_f32_32x32x16_bf16(vf, pw[kbi][h], ot[dh], 0, 0, 0);
                    }
            bf16_t* op = O + (size_t)(row0 + q) * D + hq * 64 + 4 * hi;
#pragma unroll
            for (int dh = 0; dh < 2; ++dh)
#pragma unroll
                for (int rg = 0; rg < 4; ++rg) { u32x2 w; w.x = pk2(ot[dh][4 * rg + 0] * inv, ot[dh][4 * rg + 1] * inv); w.y = pk2(ot[dh][4 * rg + 2] * inv, ot[dh][4 * rg + 3] * inv);
                    *(u32x2*)(op + dh * 32 + 8 * rg) = w; }
        }
    }
#undef AT_LOAD
    __syncthreads();
}

#define XB_TMO      128
#define XB_XCNT(j)  (256  + 64 * (j))
#define XB_XSUB(j)  (1280 + 64 * (j))
#define XB_XGEN(j)  (2304 + 64 * (j))
#define XB_TOP      3328
#define XB_TOPGEN   3392
#define XCD_BAR_WORDS 3456
#define XB_SPIN_CAP (1u << 18)

__device__ __forceinline__ unsigned xb_ld(unsigned* p)              { return __hip_atomic_load(p, __ATOMIC_RELAXED, __HIP_MEMORY_SCOPE_AGENT); }
__device__ __forceinline__ unsigned xb_add(unsigned* p, unsigned v) { return __hip_atomic_fetch_add(p, v, __ATOMIC_RELAXED, __HIP_MEMORY_SCOPE_AGENT); }
__device__ __forceinline__ unsigned xb_xcc_id() { return (unsigned)__builtin_amdgcn_s_getreg((3 << 11) | 20) & 0xFu; }
#define XB_SPIN(cond, bar) do { unsigned _sp = 0; while (cond) { __builtin_amdgcn_s_sleep(1); \
    if ((++_sp & 255u) == 0u) { if (xb_ld(&(bar)[XB_TMO])) break; if (_sp > XB_SPIN_CAP) { atomicAdd(&(bar)[XB_TMO], 1u); break; } } } } while (0)

struct XcdBarrier {
    unsigned* bar; unsigned x;
    volatile LAS unsigned* st;
};

__device__ __forceinline__ XcdBarrier xcd_barrier_post(unsigned* bar, volatile LAS unsigned* st) {
    XcdBarrier b; b.bar = bar; b.x = xb_xcc_id(); b.st = st;
    if (threadIdx.x == 0) (void)xb_add(&bar[XB_XCNT(b.x)], 1u);
    return b;
}
__device__ __forceinline__ void xcd_barrier_complete(unsigned* bar, unsigned x, unsigned& nloc, unsigned& nx) {
    const unsigned G = gridDim.x * gridDim.y * gridDim.z;
    unsigned sum, cnt, mine, sp = 0u;
    for (;;) {
        sum = 0u; cnt = 0u; mine = 0u;
#pragma unroll
        for (unsigned j = 0; j < 16; ++j) { const unsigned c = xb_ld(&bar[XB_XCNT(j)]); sum += c; cnt += (c > 0u) ? 1u : 0u; mine = (j == x) ? c : mine; }
        if (sum == G) break;
        __builtin_amdgcn_s_sleep(1);
        if ((++sp & 255u) == 0u) { if (xb_ld(&bar[XB_TMO])) break; if (sp > XB_SPIN_CAP) { atomicAdd(&bar[XB_TMO], 1u); break; } }
    }
    nloc = mine > 0u ? mine : 1u; nx = cnt > 0u ? cnt : 1u;
}

__device__ __forceinline__ void xcd_barrier(const XcdBarrier& b) {
    asm volatile("s_waitcnt vmcnt(0)" ::: "memory");
    __syncthreads();
    if (threadIdx.x == 0) {
        unsigned* bar = b.bar;
        __builtin_amdgcn_s_waitcnt(0);
        unsigned nloc = b.st[0], nx = b.st[1];
        if (nloc == 0u) { xcd_barrier_complete(bar, b.x, nloc, nx); b.st[0] = nloc; b.st[1] = nx; }
        const unsigned old = xb_add(&bar[XB_XSUB(b.x)], 1u);
        const unsigned gen = old / nloc;
        if (old + 1u == (gen + 1u) * nloc) {
            __builtin_amdgcn_fence(__ATOMIC_RELEASE, "agent");
            asm volatile("s_waitcnt vmcnt(0)" ::: "memory");
            const unsigned og = xb_add(&bar[XB_TOP], 1u);
            const unsigned tg = og / nx;
            if (og + 1u == (tg + 1u) * nx) xb_add(&bar[XB_TOPGEN], 1u);
            else XB_SPIN(xb_ld(&bar[XB_TOPGEN]) == tg, bar);
            __builtin_amdgcn_fence(__ATOMIC_ACQUIRE, "agent");
            xb_add(&bar[XB_XGEN(b.x)], 1u);
            asm volatile("s_waitcnt vmcnt(0)" ::: "memory");
        } else {
            XB_SPIN(xb_ld(&bar[XB_XGEN(b.x)]) == gen, bar);
            __builtin_amdgcn_fence(__ATOMIC_ACQUIRE, "agent");
            asm volatile("s_waitcnt vmcnt(0)" ::: "memory");
        }
    }
    __syncthreads();
}

enum { T_PRO = 0, T_ROWA, T_DIFF, T_POOLG, T_ROWB, T_QKV, T_ATTN, T_WO, T_GLU, T_FIX, T_DOWN };
constexpr int NPH = 17;
__host__ __device__ __forceinline__ void decode_phase(int ph, int& type, int& layer) {
    if (ph == 0) { type = T_PRO; layer = 0; return; }
    if (ph <= 6) { const int k = (ph - 1) % 3; layer = (ph - 1) / 3; type = (int)((0xA83ull >> (4 * k)) & 15); return; }
    const int k = (ph - 7) % 5; layer = 2 + (ph - 7) / 5; type = (int)((0xA8765ull >> (4 * k)) & 15);
}
#ifndef PH_MASK
#define PH_MASK 0xFFFF
#endif
#define PH_ON(t) (((PH_MASK) >> (t)) & 1)
#define RS_TABLE() LAS float* rsl = (LAS float*)(lds + pg8::STAGE_BYTES + 8192 + 256); int pm8 = 0; \
    { pg8::Unit u0; if (S.next(0, u0)) { pm8 = u0.pm >> 3; const float* sl_ = (const float*)(ws + WS_T) + (size_t)M * 4; \
        for (int e_ = tid; e_ < 768; e_ += NWAVES * 64) { const int pmv = u0.pm + 8 * (e_ >> 8); if (pmv < M / 256) rsl[e_] = rs_from_slots(sl_, pmv * 256 + (e_ & 255)); } } \
      __syncthreads(); }
template <bool COOP>
__global__ void __launch_bounds__(NWAVES * 64, 2) yoco_fwd(Args a) {
    extern __shared__ __attribute__((aligned(16))) unsigned char lds_raw[];
    LAS unsigned char* lds = (LAS unsigned char*)lds_raw;
    const int G = gridDim.x, blk = blockIdx.x;
    const int wave_s = __builtin_amdgcn_readfirstlane(threadIdx.x >> 6);
    volatile LAS unsigned* MISC = (volatile LAS unsigned*)(lds + pg8::STAGE_BYTES + 8192);
    if (threadIdx.x < 16) MISC[threadIdx.x] = 0u;
    __syncthreads();
    XcdBarrier xbar; xbar.bar = (unsigned*)(a.ws + WS_CTL); xbar.x = 0; xbar.st = nullptr;
    if constexpr (COOP) xbar = xcd_barrier_post((unsigned*)(a.ws + WS_CTL), MISC + 8);
    int ph0 = a.ph_lo;
    if (PH_ON(T_PRO) && ph0 == 0) {
        int lane = __builtin_amdgcn_mbcnt_hi(~0u, __builtin_amdgcn_mbcnt_lo(~0u, 0u)); asm volatile("" : "+v"(lane));
        const int wave = wave_s, tid = wave * 64 + lane;
        const int gw = blk * NWAVES + wave, NGW = G * NWAVES;
        unsigned char* ws = a.ws; asm volatile("" : "+s"(ws));
        bf16_t* BT1 = (bf16_t*)(ws + WS_BT1); bf16_t* BT2 = (bf16_t*)(ws + WS_BT2); bf16_t* BTQKV = (bf16_t*)(ws + WS_BTQKV); bf16_t* BTO = (bf16_t*)(ws + WS_BTO); bf16_t* BTP = (bf16_t*)(ws + WS_BTP);
        float* COSB = (float*)(ws + WS_COS); float* SINB = (float*)(ws + WS_SIN); bf16_t* XN = (bf16_t*)(ws + WS_XN);
        {
            LAS float* scr = (LAS float*)(lds + wave * 16384);
            constexpr int I_IN = 16 * 176, I_OUT = 44 * 32, I_Q = 16 * 32, I_KV = 16 * 16, I_O = 16 * 32, I_P = 4 * 8;
            constexpr int NITEMS = 4 * I_IN + 4 * I_OUT + 2 * I_Q + I_KV + 2 * I_O + 8 * I_P;
            for (int it = gw; it < NITEMS; it += NGW) {
                int r = it;
                if (r < 4 * I_IN) { const int l = r / I_IN; r %= I_IN; const int kb = r / 176, nbk = r % 176, n0 = nbk * 32;
                    const int bj = n0 / FF, rem = n0 % FF, pn = rem / 128, j = rem % 128;
                    transpose_item(a.ffn_w_in + (size_t)l * D * FF2, FF2, kb * 64, n0, BT1 + (size_t)l * FF2 * D, D, pn * 256 + bj * 128 + j, a.ffn_pre_g + l * D, nullptr, 1.0f, scr, lane, true); continue; }
                r -= 4 * I_IN;
                if (r < 4 * I_OUT) { const int l = r / I_OUT; r %= I_OUT; const int kb = r / 32, nbk = r % 32;
                    transpose_item(a.ffn_w_out + (size_t)l * FF * D, D, kb * 64, nbk * 32, BT2 + (size_t)l * D * FF, FF, nbk * 32, nullptr, nullptr, 1.0f, scr, lane); continue; }
                r -= 4 * I_OUT;
                if (r < 2 * I_Q) { const int j2 = r / I_Q; r %= I_Q; const int kb = r / 32, nbk = r % 32, n0 = nbk * 32;
                    const int head = n0 >> 6, half = (n0 >> 5) & 1;
                    transpose_item(a.w_q + (size_t)j2 * D * D, D, kb * 64, n0, BTQKV + (size_t)j2 * NQKV * D, D, (head >> 2) * 256 + half * 128 + (head & 3) * 32, a.mix_pre_g + (2 + j2) * D, nullptr, 0.125f * LOG2E, scr, lane, true); continue; }
                r -= 2 * I_Q;
                if (r < I_KV) { const int kb = r / 16, nbk = r % 16, n0 = nbk * 32;
                    int orow; if (n0 < 256) { const int head = n0 >> 6, half = (n0 >> 5) & 1; orow = 1024 + half * 128 + head * 32; } else orow = 1280 + (n0 - 256);
                    transpose_item(a.w_kv, 512, kb * 64, n0, BTQKV, D, orow, a.kv_norm_g, nullptr, 1.0f, scr, lane, true); continue; }
                r -= I_KV;
                if (r < 2 * I_O) { const int j2 = r / I_O; r %= I_O; const int kb = r / 32, nbk = r % 32;
                    transpose_item(a.w_o + (size_t)j2 * D * D, D, kb * 64, nbk * 32, BTO + (size_t)j2 * D * D, D, nbk * 32, nullptr, nullptr, 1.0f, scr, lane); continue; }
                r -= 2 * I_O;
                { const int lg = r / I_P; r %= I_P; const int l = lg >> 2, grp = lg & 3, kb = r / 8, nbk = r % 8;
                    transpose_item(a.pool_w + (size_t)lg * 256 * 256, 256, kb * 64, nbk * 32, BTP + (size_t)l * D * 256, 256, grp * 256 + nbk * 32, a.mix_pre_g + l * D + grp * 256, a.pool_scale + l * D + grp * 256, 1.0f, scr, lane); }
            }
            for (int idx = blk * (NWAVES * 64) + tid; idx < M * 32; idx += G * NWAVES * 64) {
                const int row = idx >> 5, i = idx & 31;
                const float ang = (float)a.positions[row] * a.inv_freq[i];
                const double ad = (double)ang; const double kq = rint(ad * 0.63661977236758134308); const double rr = ad - kq * 1.57079632679489661923;
                const double r2 = rr * rr;
                const double sv = rr * (1.0 + r2 * (-1.0 / 6 + r2 * (1.0 / 120 + r2 * (-1.0 / 5040 + r2 * (1.0 / 362880 + r2 * (-1.0 / 39916800 + r2 * (1.0 / 6227020800.0)))))));
                const double cv = 1.0 + r2 * (-0.5 + r2 * (1.0 / 24 + r2 * (-1.0 / 720 + r2 * (1.0 / 40320 + r2 * (-1.0 / 3628800 + r2 * (1.0 / 479001600.0 + r2 * (-1.0 / 87178291200.0)))))));
                const int qd = ((int)kq) & 3;
                const double c = (qd == 0) ? cv : (qd == 1) ? -sv : (qd == 2) ? -cv : sv;
                const double s = (qd == 0) ? sv : (qd == 1) ? cv : (qd == 2) ? -sv : -cv;
                COSB[idx] = (float)c; SINB[idx] = (float)s;
            }
            row_phase(a.x, nullptr, nullptr, nullptr, XN, (float*)(ws + WS_T) + (size_t)M * 4, (unsigned short*)(ws + WS_XH), gw, NGW, lane);
        }
        ph0 = 1;
        if (ph0 < a.ph_hi) { if constexpr (COOP) { cg::this_grid().sync(); } }
    }
    int rep = 0; (void)rep;
    for (int ph = ph0 < 1 ? 1 : ph0; ph < a.ph_hi; ++ph) {
        int type, layer; decode_phase(ph, type, layer);
        unsigned ones = ~0u; asm volatile("" : "+s"(ones));
        int lane = __builtin_amdgcn_mbcnt_hi(ones, __builtin_amdgcn_mbcnt_lo(ones, 0u)); asm volatile("" : "+v"(lane));
        const int wave = wave_s, tid = wave * 64 + lane;
        const int gw = blk * NWAVES + wave, NGW = G * NWAVES;
        unsigned char* ws = a.ws; asm volatile("" : "+s"(ws));
        bf16_t* BT1 = (bf16_t*)(ws + WS_BT1); bf16_t* BT2 = (bf16_t*)(ws + WS_BT2); bf16_t* BTQKV = (bf16_t*)(ws + WS_BTQKV); bf16_t* BTO = (bf16_t*)(ws + WS_BTO); bf16_t* BTP = (bf16_t*)(ws + WS_BTP);
        float* COSB = (float*)(ws + WS_COS); float* SINB = (float*)(ws + WS_SIN); float* SIDE = (float*)(ws + WS_SIDE);
        bf16_t* XN = (bf16_t*)(ws + WS_XN); bf16_t* TB = (bf16_t*)(ws + WS_T); bf16_t* KB = (bf16_t*)(ws + WS_K); bf16_t* VT = (bf16_t*)(ws + WS_VT);
        bf16_t* AB = (bf16_t*)(ws + WS_A); bf16_t* DB = AB; bf16_t* QO = AB; bf16_t* OB = AB + (size_t)M * D;
        if (false) {
        } else if (PH_ON(T_ATTN) && type == T_ATTN) {
            attn_phase(lds, QO, KB, VT, OB, a.sinks + (layer - 2) * NQH, blk, G, wave, lane, tid);
        } else if (PH_ON(T_GLU) && type == T_GLU) {
            pg8::Gemm g{(const bf16_t*)(ws + WS_XH), BT1 + (size_t)layer * FF2 * D, D, D, D, 0}; pg8::StaticOrder S; S.init(M, FF2, G, blk);
            RS_TABLE();
            pg8::EpiGlu E{AB, a.ffn_conv_w + (size_t)layer * 3 * FF2, a.ffn_conv_b + (size_t)layer * FF2, SIDE, rsl, pm8};
            pg8::gemm_phase<pg8::EpiGlu, pg8::StaticOrder, true, true>(lds, g, S, E, tid);
        } else if (PH_ON(T_QKV) && type == T_QKV) {
            pg8::Gemm g{(const bf16_t*)(ws + WS_XH), BTQKV + (size_t)(layer - 2) * NQKV * D, D, D, D, 0}; pg8::StaticOrder S; S.init(M, layer == 2 ? NQKV : D, G, blk);
            RS_TABLE();
            pg8::EpiQKV E{QO, KB, VT, COSB, SINB, rsl, pm8};
            pg8::gemm_phase<pg8::EpiQKV, pg8::StaticOrder, true, true>(lds, g, S, E, tid);
        } else if (PH_ON(T_DOWN)) {
            pg8::Gemm g; const float* gain; void* xd = (void*)(ws + WS_XH); int d16 = 1; bf16_t* xno = XN;
            if (type == T_POOLG) { g = pg8::Gemm{DB, BTP + (size_t)layer * D * 256, D, 256, 256, 256}; gain = a.mix_post_g + layer * D; }
            else if (type == T_WO) { g = pg8::Gemm{OB, BTO + (size_t)(layer - 2) * D * D, D, D, D, 0}; gain = a.mix_post_g + layer * D; }
            else { g = pg8::Gemm{AB, BT2 + (size_t)layer * D * FF, FF, FF, FF, 0}; gain = a.ffn_post_g + layer * D; if (layer == DEPTH - 1) { xno = nullptr; xd = (void*)a.out; d16 = 0; } }
            pg8::StaticOrder S; S.init(M, D, G, blk);
            { pg8::Unit uu;
              if (type == T_POOLG) { for (int i = 0; S.next(i, uu); ++i) diff_tile((const bf16_t*)(ws + WS_XH), (const float*)(ws + WS_T) + (size_t)M * 4, DB, uu.pm, uu.pn, tid); }
              else if (type == T_DOWN) { for (int i = 0; S.next(i, uu); ++i) fixup_tile(SIDE, a.ffn_conv_w + (size_t)layer * 3 * FF2, a.ffn_conv_b + (size_t)layer * FF2, AB, uu.pm, tid); }
              asm volatile("s_waitcnt vmcnt(0)" ::: "memory"); __syncthreads(); }
            unsigned* ctl = (unsigned*)(ws + WS_CTL);
            int bank = 2 * ph;
#if defined(PROBE_DUP)
            if ((((PROBE_DUP) >> type) & 1) && rep == 0) { gain = (const float*)(ws + WS_CTL + 3584 * 1024); bank += 46; }
#endif
            pg8::RowStats st1{(float*)(ws + WS_T), ctl + CW_SEAM + bank * 8192}, st2{(float*)(ws + WS_T) + (size_t)M * 4, ctl + CW_SEAM + (bank + 1) * 8192};
            pg8::EpiResNorm E{(const unsigned short*)(ws + WS_XH), xd, d16, xno, gain, st1, st2};
            pg8::gemm_phase<pg8::EpiResNorm, pg8::StaticOrder, true, true>(lds, g, S, E, tid);
        }
        if (ph + 1 < a.ph_hi) {
            if constexpr (COOP) { xcd_barrier(xbar); }
        }
#if defined(PROBE_DUP)
        if ((((PROBE_DUP) >> type) & 1) && rep == 0) { rep = 1; --ph; } else rep = 0;
#endif
    }
}

extern "C" void kernel_launch(void* const* d_in, const int* in_sizes, int n_in, void* d_out, int out_size, void* d_ws, size_t ws_size, hipStream_t stream) {
    static int grid = 0;
    static float invf[32];
    if (grid == 0) {
        if (n_in != 17 || out_size != M * D || ws_size < WS_END) { fprintf(stderr, "kernel_launch: unexpected shapes (n_in %d, out %d, ws %zu)\n", n_in, out_size, ws_size); grid = -1; return; }
        int dev = 0, cus = 0, per_cu = 0;
        (void)hipGetDevice(&dev); (void)hipDeviceGetAttribute(&cus, hipDeviceAttributeMultiprocessorCount, dev);
#if defined(MK_PER_PHASE)
        const void* kfn = (const void*)yoco_fwd<false>;
#else
        const void* kfn = (const void*)yoco_fwd<true>;
#endif
        (void)hipFuncSetAttribute(kfn, hipFuncAttributeMaxDynamicSharedMemorySize, LDS_BYTES);
        (void)hipOccupancyMaxActiveBlocksPerMultiprocessor(&per_cu, kfn, NWAVES * 64, LDS_BYTES);
        if (per_cu < 1) { fprintf(stderr, "kernel_launch: occupancy query says %d blocks per CU\n", per_cu); per_cu = 1; }
        (void)hipGetLastError();
        grid = cus * per_cu;
        for (int i = 0; i < 32; ++i) invf[i] = 1.0f / powf(10000.0f, (float)(2 * i) / 64.0f);
    }
    if (grid < 0) return;
    Args a{};
    a.x = (const float*)d_in[0]; a.positions = (const int*)d_in[1]; a.mix_pre_g = (const float*)d_in[2]; a.mix_post_g = (const float*)d_in[3]; a.pool_w = (const float*)d_in[4];
    a.pool_scale = (const float*)d_in[5]; a.kv_norm_g = (const float*)d_in[6]; a.w_kv = (const float*)d_in[7]; a.w_q = (const float*)d_in[8]; a.w_o = (const float*)d_in[9];
    a.sinks = (const float*)d_in[10]; a.ffn_pre_g = (const float*)d_in[11]; a.ffn_post_g = (const float*)d_in[12]; a.ffn_w_in = (const float*)d_in[13]; a.ffn_conv_w = (const float*)d_in[14];
    a.ffn_conv_b = (const float*)d_in[15]; a.ffn_w_out = (const float*)d_in[16];
    a.out = (float*)d_out; a.ws = (unsigned char*)d_ws;
    for (int i = 0; i < 32; ++i) a.inv_freq[i] = invf[i];
#if defined(MK_PER_PHASE)
    for (int ph = 0; ph < NPH; ++ph) { a.ph_lo = ph; a.ph_hi = ph + 1; hipLaunchKernelGGL(yoco_fwd<false>, dim3(grid), dim3(NWAVES * 64), LDS_BYTES, stream, a); }
#else
    a.ph_lo = 0; a.ph_hi = NPH;
    (void)hipMemsetAsync((char*)d_ws + WS_CTL, 0, CTL_BYTES, stream);
    void* args[] = {&a};
    hipError_t e = hipLaunchCooperativeKernel((const void*)yoco_fwd<true>, dim3(grid), dim3(NWAVES * 64), args, LDS_BYTES, stream);
    if (e != hipSuccess) fprintf(stderr, "cooperative launch failed: %s (grid %d)\n", hipGetErrorString(e), grid);
#endif
}
```
